# Optimizing an MI355X kernel written in HIP

```python
import math
import jax, jax.numpy as jnp
from jax import lax
import numpy as np

D_MODEL = 1024
BATCH = 8
SEQ = 8192
DEPTH = 2

GRID_W = 64
CTX_LEN = 256
N_BRANCH = 4
BRANCH_W = 256
EPS = 1e-6
ROPE_BASE = 10000.0
BLOCK = 128
NEG_INF = -1e30

POOL_WINDOWS = (2, 4, 8, 16)
POOL_GROUP = BRANCH_W // len(POOL_WINDOWS)

MLA_HEADS = 4
MLA_NOPE = 64
MLA_ROPE = 32
MLA_V = 64
MLA_Q_RANK = 192
MLA_KV_RANK = 128

DIFF_HEADS = 4
DIFF_QK = 32
DIFF_V = 2 * DIFF_QK

SWA_HEADS = 4
SWA_KV_HEADS = 2
SWA_HEAD = 64
SWA_WINDOW = 128

SPLITS = (
    ('pool_in', BRANCH_W),
    ('mla_cq', MLA_Q_RANK),
    ('mla_ckv', MLA_KV_RANK),
    ('mla_kr', MLA_ROPE),
    ('diff_q', DIFF_HEADS * 2 * DIFF_QK),
    ('diff_k', DIFF_HEADS * 2 * DIFF_QK),
    ('diff_v', DIFF_HEADS * DIFF_V),
    ('swa_q', SWA_HEADS * SWA_HEAD),
    ('swa_k', SWA_KV_HEADS * SWA_HEAD),
    ('swa_v', SWA_KV_HEADS * SWA_HEAD),
    ('gates', N_BRANCH * BRANCH_W),
    ('merge', N_BRANCH * D_MODEL),
)
IN_COLS = sum(w for _, w in SPLITS)

kernel_name = 'hybrid_pool_mla_diff_swa_prefix_block'


def rms_norm(x, g):
    xf = x.astype(jnp.float32)
    y = xf * lax.rsqrt(jnp.mean(xf * xf, axis=-1, keepdims=True) + EPS)
    return (y * g.astype(jnp.float32)).astype(x.dtype)


def split_cols(z):
    out, off = {}, 0
    for name, w in SPLITS:
        out[name] = z[..., off:off + w]
        off += w
    return out


def axial_rope_tables(n_tok, rot_dim, dtype):
    t = jnp.arange(n_tok, dtype=jnp.int32)
    row = (t // GRID_W).astype(jnp.float32)
    col = (t % GRID_W).astype(jnp.float32)
    n_freq = rot_dim // 4
    inv_freq = jnp.exp(-math.log(ROPE_BASE) * jnp.arange(n_freq, dtype=jnp.float32) / n_freq)
    ang = jnp.concatenate([row[:, None] * inv_freq, col[:, None] * inv_freq], axis=-1)
    return jnp.cos(ang).astype(dtype), jnp.sin(ang).astype(dtype)


def apply_rope(x, cos, sin):
    half = x.shape[-1] // 2
    x1, x2 = x[..., :half], x[..., half:]
    c = cos[None, :, None, :]
    s = sin[None, :, None, :]
    return jnp.concatenate([x1 * c - x2 * s, x1 * s + x2 * c], axis=-1)


def pool_mixer(u, w_pool, s_pool):
    B, N, W = u.shape
    uf = u.astype(jnp.float32)
    cs = jnp.concatenate([jnp.zeros((B, 1, W), jnp.float32), jnp.cumsum(uf, axis=1)], axis=1)
    t = jnp.arange(N, dtype=jnp.int32)
    groups = []
    for gi, w in enumerate(POOL_WINDOWS):
        lo = jnp.clip(t - w // 2, 0, N)
        hi = jnp.clip(t - w // 2 + w, 0, N)
        sl = slice(gi * POOL_GROUP, (gi + 1) * POOL_GROUP)
        csg = cs[..., sl]
        win_sum = jnp.take(csg, hi, axis=1) - jnp.take(csg, lo, axis=1)
        mean = win_sum / (hi - lo).astype(jnp.float32)[None, :, None]
        groups.append(mean - uf[..., sl])
    y = jnp.stack(groups, axis=2).astype(u.dtype)
    y = jnp.einsum('bngc,gcd->bngd', y, w_pool).reshape(B, N, W)
    return y * s_pool


def dense_attention(q, k, v, coef, scale):
    M, B, S, H, D = q.shape
    nb = S // BLOCK
    qb = jnp.moveaxis(q.reshape(M, B, nb, BLOCK, H, D), 2, 0)
    cf = coef.astype(jnp.float32)

    def one(q_blk):
        s = jnp.einsum('mbqhd,mbkhd->mbhqk', q_blk, k).astype(jnp.float32) * scale
        p = jnp.einsum('m,mbhqk->bhqk', cf, jax.nn.softmax(s, axis=-1))
        return jnp.einsum('bhqk,bkhd->bqhd', p.astype(v.dtype), v)

    o = lax.map(one, qb)
    return jnp.moveaxis(o, 0, 1).reshape(B, S, H, v.shape[-1])


def sink_attend(q, keys, values, masks, sink_hg, scale):
    scores = []
    for k, m in zip(keys, masks):
        s = jnp.einsum('bqhgd,bkhd->bhgqk', q, k).astype(jnp.float32) * scale
        if m is not None:
            s = jnp.where(m, s, NEG_INF)
        scores.append(s)
    s_sink = jnp.broadcast_to(sink_hg[None, :, :, None, None], scores[0].shape[:-1] + (1,))
    p = jax.nn.softmax(jnp.concatenate(scores + [s_sink], axis=-1), axis=-1)
    outs, off = [], 0
    for s, v in zip(scores, values):
        n = s.shape[-1]
        outs.append(jnp.einsum('bhgqk,bkhd->bqhgd', p[..., off:off + n].astype(v.dtype), v))
        off += n
    return sum(outs)


def windowed_attention(q, k, v, k_ctx, v_ctx, sink_hg):
    B, S, Hkv, G, D = q.shape
    nb = S // BLOCK
    scale = D ** -0.5
    qb = jnp.moveaxis(q.reshape(B, nb, BLOCK, Hkv, G, D), 1, 0)
    pad = ((0, 0), (BLOCK, BLOCK), (0, 0), (0, 0))
    kp = jnp.pad(k, pad).reshape(B, nb + 2, BLOCK, Hkv, D)
    vp = jnp.pad(v, pad).reshape(B, nb + 2, BLOCK, Hkv, D)
    kw = jnp.moveaxis(jnp.concatenate([kp[:, :-2], kp[:, 1:-1], kp[:, 2:]], axis=2), 1, 0)
    vw = jnp.moveaxis(jnp.concatenate([vp[:, :-2], vp[:, 1:-1], vp[:, 2:]], axis=2), 1, 0)
    a = jnp.arange(BLOCK)[:, None]
    j = jnp.arange(3 * BLOCK)[None, :]
    band = jnp.abs(a + BLOCK - j) <= SWA_WINDOW
    kpos = (jnp.arange(nb)[:, None] - 1) * BLOCK + jnp.arange(3 * BLOCK)[None, :]
    inside = (kpos >= 0) & (kpos < S)
    mask = band[None] & inside[:, None, :]

    def one(args):
        qi, ki, vi, mi = args
        return sink_attend(qi, [k_ctx, ki], [v_ctx, vi], [None, mi], sink_hg, scale)

    o = lax.map(one, (qb, kw, vw, mask))
    return jnp.moveaxis(o, 0, 1).reshape(B, S, Hkv * G * D)


def hybrid_layer(layer_idx, x, xc, c, c_ctx, w_mod, b_mod, g_pre, g_post, w_in, w_pool, s_pool,
                 g_cq, w_uq, g_ckv, w_uk, w_uv, lam_q1, lam_k1, lam_q2, lam_k2, g_diff,
                 sink, w_br, w_out, need_ctx):
    B, S, D = x.shape
    C = xc.shape[1]
    G = SWA_HEADS // SWA_KV_HEADS
    f32 = jnp.float32

    shift, scale, gate = jnp.split(jax.nn.silu(c) @ w_mod + b_mod, 3, axis=-1)
    shift_c, scale_c, gate_c = jnp.split(jax.nn.silu(c_ctx) @ w_mod + b_mod, 3, axis=-1)
    h = rms_norm(x, g_pre) * (1 + scale[:, None, :]) + shift[:, None, :]
    hc = rms_norm(xc, g_pre) * (1 + scale_c) + shift_c
    z = split_cols(h @ w_in)
    zc = split_cols(hc @ w_in)

    rope_tab = {d: axial_rope_tables(S, d, x.dtype) for d in (MLA_ROPE, DIFF_QK, SWA_HEAD)}

    def rot(t, d):
        return apply_rope(t, *rope_tab[d])

    def mla_q(zz, pos):
        n = zz['mla_cq'].shape[1]
        q = (rms_norm(zz['mla_cq'], g_cq) @ w_uq).reshape(B, n, MLA_HEADS, MLA_NOPE + MLA_ROPE)
        q_rope = rot(q[..., MLA_NOPE:], MLA_ROPE) if pos else q[..., MLA_NOPE:]
        return jnp.concatenate([q[..., :MLA_NOPE], q_rope], axis=-1)

    def mla_kv(zz, pos):
        n = zz['mla_ckv'].shape[1]
        ckv = rms_norm(zz['mla_ckv'], g_ckv)
        k_nope = (ckv @ w_uk).reshape(B, n, MLA_HEADS, MLA_NOPE)
        v = (ckv @ w_uv).reshape(B, n, MLA_HEADS, MLA_V)
        k_rope = zz['mla_kr'][:, :, None, :]
        if pos:
            k_rope = rot(k_rope, MLA_ROPE)
        k = jnp.concatenate([k_nope, jnp.broadcast_to(k_rope, (B, n, MLA_HEADS, MLA_ROPE))], axis=-1)
        return k, v

    one_map = jnp.ones((1,), f32)
    mla_scale = (MLA_NOPE + MLA_ROPE) ** -0.5
    k_mc, v_mc = mla_kv(zc, False)
    k_ml, v_ml = mla_kv(z, True)
    y_mla = dense_attention(mla_q(z, True)[None], jnp.concatenate([k_mc, k_ml], axis=1)[None],
                            jnp.concatenate([v_mc, v_ml], axis=1), one_map, mla_scale).reshape(B, S, MLA_HEADS * MLA_V)

    def diff_split(t, pos):
        n = t.shape[1]
        t = t.reshape(B, n, DIFF_HEADS * 2, DIFF_QK)
        if pos:
            t = rot(t, DIFF_QK)
        return jnp.moveaxis(t.reshape(B, n, DIFF_HEADS, 2, DIFF_QK), 3, 0)

    lam_init = 0.8 - 0.6 * math.exp(-0.3 * layer_idx)
    lam = (jnp.exp(jnp.sum(lam_q1.astype(f32) * lam_k1.astype(f32)))
           - jnp.exp(jnp.sum(lam_q2.astype(f32) * lam_k2.astype(f32))) + lam_init)
    diff_coef = jnp.stack([jnp.ones((), f32), -lam])

    def diff_out(o):
        return (rms_norm(o, g_diff) * (1 - lam_init)).reshape(B, o.shape[1], DIFF_HEADS * DIFF_V)

    k_dc = diff_split(zc['diff_k'], False)
    v_dc = zc['diff_v'].reshape(B, C, DIFF_HEADS, DIFF_V)
    k_dl = diff_split(z['diff_k'], True)
    v_dl = z['diff_v'].reshape(B, S, DIFF_HEADS, DIFF_V)
    y_diff = diff_out(dense_attention(diff_split(z['diff_q'], True), jnp.concatenate([k_dc, k_dl], axis=2),
                                      jnp.concatenate([v_dc, v_dl], axis=1), diff_coef, DIFF_QK ** -0.5))

    sink_hg = sink.astype(f32).reshape(SWA_KV_HEADS, G)

    def swa_q(zz, pos):
        n = zz['swa_q'].shape[1]
        q = zz['swa_q'].reshape(B, n, SWA_HEADS, SWA_HEAD)
        if pos:
            q = rot(q, SWA_HEAD)
        return q.reshape(B, n, SWA_KV_HEADS, G, SWA_HEAD)

    def swa_kv(zz, pos):
        n = zz['swa_k'].shape[1]
        k = zz['swa_k'].reshape(B, n, SWA_KV_HEADS, SWA_HEAD)
        if pos:
            k = rot(k, SWA_HEAD)
        return k, zz['swa_v'].reshape(B, n, SWA_KV_HEADS, SWA_HEAD)

    k_sc, v_sc = swa_kv(zc, False)
    k_sl, v_sl = swa_kv(z, True)
    y_swa = windowed_attention(swa_q(z, True), k_sl, v_sl, k_sc, v_sc, sink_hg)

    y_pool = pool_mixer(z['pool_in'], w_pool, s_pool)

    def merge(ys, zz):
        n = zz['gates'].shape[1]
        gates = jax.nn.silu(zz['gates']).reshape(B, n, N_BRANCH, BRANCH_W)
        mgate = jax.nn.sigmoid(zz['merge']).reshape(B, n, N_BRANCH, D)
        m = sum(mgate[:, :, r] * ((ys[r] * gates[:, :, r]) @ w_br[r]) for r in range(N_BRANCH))
        return rms_norm(m @ w_out, g_post)

    x_new = x + gate[:, None, :] * merge([y_pool, y_mla, y_diff, y_swa], z)

    if need_ctx:
        yc_pool = pool_mixer(zc['pool_in'], w_pool, s_pool)
        yc_mla = dense_attention(mla_q(zc, False)[None], k_mc[None], v_mc, one_map,
                                 mla_scale).reshape(B, C, MLA_HEADS * MLA_V)
        yc_diff = diff_out(dense_attention(diff_split(zc['diff_q'], False), k_dc, v_dc, diff_coef, DIFF_QK ** -0.5))
        yc_swa = sink_attend(swa_q(zc, False), [k_sc], [v_sc], [None], sink_hg,
                             SWA_HEAD ** -0.5).reshape(B, C, SWA_HEADS * SWA_HEAD)
        xc = xc + gate_c * merge([yc_pool, yc_mla, yc_diff, yc_swa], zc)
    return x_new, xc


def setup_inputs(seed: int = 0) -> dict:
    key = jax.random.key(seed)
    ks = jax.random.split(key, 24)
    L = DEPTH

    def nrm(k, shape, s):
        return jax.random.normal(k, shape, jnp.float32) * s

    return {
        'x': nrm(ks[0], (BATCH, SEQ, D_MODEL), 1.0),
        'c': nrm(ks[1], (BATCH, D_MODEL), 1.0),
        'ctx': nrm(ks[2], (BATCH, CTX_LEN, D_MODEL), 1.0),
        'c_ctx': nrm(ks[3], (D_MODEL,), 1.0),
        'w_mod': nrm(ks[4], (L, D_MODEL, 3 * D_MODEL), 0.5 * D_MODEL ** -0.5),
        'b_mod': nrm(ks[5], (L, 3 * D_MODEL), 0.01),
        'g_pre': 1.0 + nrm(ks[6], (L, D_MODEL), 0.05),
        'g_post': 1.0 + nrm(ks[7], (L, D_MODEL), 0.05),
        'w_in': nrm(ks[8], (L, D_MODEL, IN_COLS), D_MODEL ** -0.5),
        'w_pool': nrm(ks[9], (L, len(POOL_WINDOWS), POOL_GROUP, POOL_GROUP), POOL_GROUP ** -0.5),
        's_pool': 1.0 + nrm(ks[10], (L, BRANCH_W), 0.05),
        'g_cq': 1.0 + nrm(ks[11], (L, MLA_Q_RANK), 0.05),
        'w_uq': nrm(ks[12], (L, MLA_Q_RANK, MLA_HEADS * (MLA_NOPE + MLA_ROPE)), MLA_Q_RANK ** -0.5),
        'g_ckv': 1.0 + nrm(ks[13], (L, MLA_KV_RANK), 0.05),
        'w_uk': nrm(ks[14], (L, MLA_KV_RANK, MLA_HEADS * MLA_NOPE), MLA_KV_RANK ** -0.5),
        'w_uv': nrm(ks[15], (L, MLA_KV_RANK, MLA_HEADS * MLA_V), MLA_KV_RANK ** -0.5),
        'lam_q1': nrm(ks[16], (L, DIFF_QK), 0.1),
        'lam_k1': nrm(ks[17], (L, DIFF_QK), 0.1),
        'lam_q2': nrm(ks[18], (L, DIFF_QK), 0.1),
        'lam_k2': nrm(ks[19], (L, DIFF_QK), 0.1),
        'g_diff': 1.0 + nrm(ks[20], (L, DIFF_V), 0.05),
        'sink': nrm(ks[21], (L, SWA_HEADS), 0.5),
        'w_br': nrm(ks[22], (L, N_BRANCH, BRANCH_W, D_MODEL), BRANCH_W ** -0.5),
        'w_out': nrm(ks[23], (L, D_MODEL, D_MODEL), D_MODEL ** -0.5),
    }


def reference(x, c, ctx, c_ctx, w_mod, b_mod, g_pre, g_post, w_in, w_pool, s_pool, g_cq, w_uq, g_ckv,
              w_uk, w_uv, lam_q1, lam_k1, lam_q2, lam_k2, g_diff, sink, w_br, w_out):
    xc = ctx
    for l in range(DEPTH):
        x, xc = hybrid_layer(l, x, xc, c, c_ctx, w_mod[l], b_mod[l], g_pre[l], g_post[l], w_in[l],
                             w_pool[l], s_pool[l], g_cq[l], w_uq[l], g_ckv[l], w_uk[l], w_uv[l],
                             lam_q1[l], lam_k1[l], lam_q2[l], lam_k2[l], g_diff[l], sink[l],
                             w_br[l], w_out[l], l < DEPTH - 1)
    return x
```

```cpp
#include <hip/hip_runtime.h>
#include <hip/hip_cooperative_groups.h>
#include <stdint.h>
#include <stdio.h>
namespace cg = cooperative_groups;

#ifndef SINGLE_LAUNCH
#define SINGLE_LAUNCH 1
#endif

typedef unsigned short bf16_t;
using bf16x8 = __attribute__((ext_vector_type(8))) short;
using f32x16 = __attribute__((ext_vector_type(16))) float;
using u32x4  = __attribute__((ext_vector_type(4))) unsigned;
using u32x2  = __attribute__((ext_vector_type(2))) unsigned;
#define DI __device__ __forceinline__
#define MFMA(a, b, c) __builtin_amdgcn_mfma_f32_32x32x16_bf16((a), (b), (c), 0, 0, 0)

constexpr int DM = 1024, NBATCH = 8, SEQ = 8192, CL = 256;
constexpr int TL = NBATCH * SEQ;
constexpr int TC = NBATCH * CL;
constexpr int T  = TL + TC;
constexpr int KV = SEQ + CL;
constexpr int INC = 7008;
constexpr int ZW = 1536;
constexpr int Z_POOL = 0, Z_CQ = 256, Z_CKV = 448, Z_KR = 576, Z_DQ = 608, Z_DK = 864, Z_SQ = 1120, Z_SK = 1376;
constexpr int WIN_ROWS = 7040;
constexpr int WR_J2 = 1536, WR_G = 1920, WR_M = 2944;
constexpr float EPS = 1e-6f;
constexpr float LOG2E = 1.4426950408889634f;

constexpr size_t al(size_t x) { return (x + 255) & ~(size_t)255; }
constexpr size_t OFF_WINT = 0;
constexpr size_t OFF_WBRT = al(OFF_WINT + (size_t)2 * WIN_ROWS * 1024 * 2);
constexpr size_t OFF_WOUT = al(OFF_WBRT + (size_t)2 * 4 * 1024 * 256 * 2);
constexpr size_t OFF_WUQT = al(OFF_WOUT + (size_t)2 * 1024 * 1024 * 2);
constexpr size_t OFF_WUKT = al(OFF_WUQT + (size_t)2 * 384 * 192 * 2);
constexpr size_t OFF_WUVT = al(OFF_WUKT + (size_t)2 * 256 * 128 * 2);
constexpr size_t OFF_WPL  = al(OFF_WUVT + (size_t)2 * 256 * 128 * 2);
constexpr size_t OFF_MODV = al(OFF_WPL + (size_t)2 * 256 * 256 * 2);
constexpr size_t OFF_TR32 = al(OFF_MODV + (size_t)2 * 9 * 3072 * 4);
constexpr size_t OFF_TR64 = al(OFF_TR32 + (size_t)128 * 8 * 8);
constexpr size_t OFF_LAMV = al(OFF_TR64 + (size_t)128 * 16 * 8);
constexpr size_t OFF_XC1  = al(OFF_LAMV + 256);
constexpr size_t OFF_H    = al(OFF_XC1 + (size_t)TC * 1024 * 4);
constexpr size_t OFF_Z1   = al(OFF_H + (size_t)T * 1024 * 2);
constexpr size_t OFF_MBUF = OFF_Z1;
constexpr size_t OFF_CQN  = al(OFF_Z1 + (size_t)T * ZW * 2);
constexpr size_t OFF_CKVN = al(OFF_CQN + (size_t)T * 192 * 2);
constexpr size_t OFF_PD   = al(OFF_CKVN + (size_t)T * 128 * 2);
constexpr size_t OFF_QM   = al(OFF_PD + (size_t)T * 256 * 2);
constexpr size_t OFF_O    = OFF_QM;
constexpr size_t OFF_KM   = al(OFF_QM + (size_t)T * 384 * 2);
constexpr size_t OFF_VTM  = al(OFF_KM + (size_t)NBATCH * KV * 384 * 2);
constexpr size_t OFF_QD   = al(OFF_VTM + (size_t)NBATCH * 256 * KV * 2);
constexpr size_t OFF_KD   = al(OFF_QD + (size_t)T * 256 * 2);
constexpr size_t OFF_VTD  = al(OFF_KD + (size_t)NBATCH * KV * 256 * 2);
constexpr size_t OFF_QS   = al(OFF_VTD + (size_t)NBATCH * 256 * KV * 2);
constexpr size_t OFF_KS   = al(OFF_QS + (size_t)T * 256 * 2);
constexpr size_t OFF_VTS  = al(OFF_KS + (size_t)NBATCH * KV * 128 * 2);
constexpr size_t OFF_Y    = al(OFF_VTS + (size_t)NBATCH * 128 * KV * 2);
constexpr size_t OFF_BAR  = al(OFF_Y + (size_t)T * 1024 * 2);
constexpr size_t WS_END   = al(OFF_BAR + 16384);
static_assert(OFF_O + (size_t)T * 1024 * 2 <= OFF_QD, "o alias overflows");

struct P {
  const float *x, *c, *ctx, *cctx, *w_mod, *b_mod, *g_pre, *g_post, *w_in, *w_pool, *s_pool, *g_cq, *w_uq, *g_ckv, *w_uk, *w_uv;
  const float *lq1, *lk1, *lq2, *lk2, *g_diff, *sink, *w_br, *w_out;
  float* out;
  char* ws;
  int phase_lo, phase_hi;
};

typedef __bf16 bf16v2 __attribute__((ext_vector_type(2)));
typedef float f32v2 __attribute__((ext_vector_type(2)));
DI unsigned cvtpk(float lo, float hi) { f32v2 v = {lo, hi}; bf16v2 r = __builtin_convertvector(v, bf16v2); return __builtin_bit_cast(unsigned, r); }
DI float bflo(unsigned u) { return __uint_as_float(u << 16); }
DI float bfhi(unsigned u) { return __uint_as_float(u & 0xffff0000u); }
DI void unpack8(u32x4 v, float* f) {
#pragma unroll
  for (int i = 0; i < 4; ++i) { f[2 * i] = bflo(v[i]); f[2 * i + 1] = bfhi(v[i]); }
}
DI u32x4 pack8(const float* f) { u32x4 v = {cvtpk(f[0], f[1]), cvtpk(f[2], f[3]), cvtpk(f[4], f[5]), cvtpk(f[6], f[7])}; return v; }
DI float wave_sum(float v) {
#pragma unroll
  for (int o = 32; o > 0; o >>= 1) v += __shfl_xor(v, o);
  return v;
}
DI float xhalf_max(float v) { auto rr = __builtin_amdgcn_permlane32_swap(__float_as_uint(v), __float_as_uint(v), false, false); return fmaxf(__uint_as_float(rr[0]), __uint_as_float(rr[1])); }
DI float xhalf_sum(float v) { auto rr = __builtin_amdgcn_permlane32_swap(__float_as_uint(v), __float_as_uint(v), false, false); return __uint_as_float(rr[0]) + __uint_as_float(rr[1]); }
DI void tok2bk(int t, int& b, int& key) {
  if (t < TL) { b = t >> 13; key = CL + (t & (SEQ - 1)); } else { int u = t - TL; b = u >> 8; key = u & (CL - 1); }
}
DI int ltid() { int t = threadIdx.x; asm volatile("" : "+v"(t)); return t; }
DI float sigmoidf_(float x) { return __builtin_amdgcn_rcpf(1.f + __expf(-x)); }

DI void gemm_stage(const bf16_t* A, int lda, const bf16_t* B, int ldb, char* bufA, int tid_) {
  int tid = tid_;
  asm volatile("" : "+v"(tid));
#pragma unroll
  for (int i = 0; i < 4; ++i) {
    const int p = tid + 256 * i, row = p >> 3, lc = (p & 7) ^ ((row >> 1) & 7);
    const unsigned oa = (unsigned)(row * lda + lc * 8) * 2u, ob = (unsigned)(row * ldb + lc * 8) * 2u;
    __builtin_amdgcn_global_load_lds((const unsigned*)((const char*)A + oa), (unsigned*)(bufA + p * 16), 16, 0, 0);
    __builtin_amdgcn_global_load_lds((const unsigned*)((const char*)B + ob), (unsigned*)(bufA + 16384 + p * 16), 16, 0, 0);
  }
}
using f32x4m = __attribute__((ext_vector_type(4))) float;
DI bool gemm_tile(f32x16 (&acc)[2][2], const bf16_t* A, int lda, const bf16_t* B, int ldb, int K, char* lds, bool prefetched,
                  const bf16_t* nA, int nlda, const bf16_t* nB, int nldb) {
  const int tid = ltid(), lane = tid & 63, w = tid >> 6, wm = w >> 1, wn = w & 1, fr = lane & 15, fq = lane >> 4;
  const int sw = (fr >> 1) & 7;
  const int nk = K >> 6;
  const bool chain = (nA != nullptr) && ((nk & 1) == 0);
  f32x4m c[4][4];
#pragma unroll
  for (int mi = 0; mi < 4; ++mi)
#pragma unroll
    for (int ni = 0; ni < 4; ++ni)
#pragma unroll
      for (int j = 0; j < 4; ++j) { const int L = (mi * 4 + ni) * 4 + j; c[mi][ni][j] = acc[L >> 5][(L >> 4) & 1][L & 15]; }
  if (!prefetched) {
    __syncthreads();
    gemm_stage(A, lda, B, ldb, lds + 34816, tid);
  }
  for (int kt = 0; kt < nk; ++kt) {
    asm volatile("s_waitcnt vmcnt(0)" ::: "memory");
    __syncthreads();
    if (kt + 1 < nk) gemm_stage(A + (kt + 1) * 64, lda, B + (kt + 1) * 64, ldb, lds + (((kt + 1) & 1) ? 0 : 34816), tid);
    else if (chain) gemm_stage(nA, nlda, nB, nldb, lds + 34816, tid);
    const char* As = lds + ((kt & 1) ? 0 : 34816);
    const char* Bs = As + 16384;
#pragma unroll
    for (int kk = 0; kk < 2; ++kk) {
      bf16x8 af[4], bfr[4];
      const int co = ((4 * kk + fq) ^ sw) << 4;
#pragma unroll
      for (int mi = 0; mi < 4; ++mi) af[mi] = *(const bf16x8*)(As + (wm * 64 + mi * 16 + fr) * 128 + co);
#pragma unroll
      for (int ni = 0; ni < 4; ++ni) bfr[ni] = *(const bf16x8*)(Bs + (wn * 64 + ni * 16 + fr) * 128 + co);
      __builtin_amdgcn_s_setprio(1);
#pragma unroll
      for (int mi = 0; mi < 4; ++mi)
#pragma unroll
        for (int ni = 0; ni < 4; ++ni) c[mi][ni] = __builtin_amdgcn_mfma_f32_16x16x32_bf16(af[mi], bfr[ni], c[mi][ni], 0, 0, 0);
      __builtin_amdgcn_s_setprio(0);
    }
  }
#pragma unroll
  for (int mi = 0; mi < 4; ++mi)
#pragma unroll
    for (int ni = 0; ni < 4; ++ni)
#pragma unroll
      for (int j = 0; j < 4; ++j) { const int L = (mi * 4 + ni) * 4 + j; acc[L >> 5][(L >> 4) & 1][L & 15] = c[mi][ni][j]; }
  return chain;
}

DI void zero_acc(f32x16 (&acc)[2][2]) {
#pragma unroll
  for (int a = 0; a < 2; ++a)
#pragma unroll
    for (int b = 0; b < 2; ++b)
#pragma unroll
      for (int i = 0; i < 16; ++i) acc[a][b][i] = 0.f;
}

DI void lds_barrier() { asm volatile("s_waitcnt lgkmcnt(0)" ::: "memory"); __builtin_amdgcn_s_barrier(); asm volatile("" ::: "memory"); }
template <class Epi>
DI void store_tile(f32x16 (&acc)[2][2], int m0, int n0, char* lds, const Epi& epi) {
  const int tid = ltid(), lane = tid & 63, w = tid >> 6, wm = w >> 1, wn = w & 1, r = lane & 31, h = lane >> 5;
  lds_barrier();
#pragma unroll
  for (int mi = 0; mi < 2; ++mi)
#pragma unroll
    for (int ni = 0; ni < 2; ++ni)
#pragma unroll
      for (int g = 0; g < 4; ++g) {
        u32x2 v = {cvtpk(acc[mi][ni][4 * g], acc[mi][ni][4 * g + 1]), cvtpk(acc[mi][ni][4 * g + 2], acc[mi][ni][4 * g + 3])};
        *(u32x2*)(lds + (wn * 64 + ni * 32 + r) * 272 + (wm * 64 + mi * 32 + 8 * g + 4 * h) * 2) = v;
      }
  lds_barrier();
#pragma unroll
  for (int i = 0; i < 8; ++i) {
    int e = tid + 256 * i, nl = e >> 4, mc = e & 15;
    u32x4 v = *(const u32x4*)(lds + nl * 272 + mc * 16);
    epi(n0 + nl, m0 + mc * 8, v);
  }
}

template <class Epi>
DI void store_tile16(f32x16 (&acc)[2][2], int m0, int n0, char* lds, const Epi& epi) {
  const int tid = ltid(), lane = tid & 63, w = tid >> 6, wm = w >> 1, wn = w & 1, fr = lane & 15, fq = lane >> 4;
  lds_barrier();
#pragma unroll
  for (int mi = 0; mi < 4; ++mi)
#pragma unroll
    for (int ni = 0; ni < 4; ++ni) {
      const int L = (mi * 4 + ni) * 4;
      u32x2 v = {cvtpk(acc[L >> 5][(L >> 4) & 1][L & 15], acc[L >> 5][(L >> 4) & 1][(L & 15) + 1]),
                 cvtpk(acc[L >> 5][(L >> 4) & 1][(L & 15) + 2], acc[L >> 5][(L >> 4) & 1][(L & 15) + 3])};
      *(u32x2*)(lds + (wn * 64 + ni * 16 + fr) * 272 + (wm * 64 + mi * 16 + fq * 4) * 2) = v;
    }
  lds_barrier();
#pragma unroll
  for (int i = 0; i < 8; ++i) {
    int e = tid + 256 * i, nl = e >> 4, mc = e & 15;
    u32x4 v = *(const u32x4*)(lds + nl * 272 + mc * 16);
    epi(n0 + nl, m0 + mc * 8, v);
  }
}

template <class Epi>
DI void store_tile16_big(f32x16 (&acc)[4][2], int m0, int n0, char* lds, const Epi& epi) {
  const int tid = ltid(), lane = tid & 63, w = tid >> 6, wm = w >> 1, wn = w & 1, fr = lane & 15, fq = lane >> 4;
  lds_barrier();
#pragma unroll
  for (int hh = 0; hh < 2; ++hh)
#pragma unroll
    for (int mi = 0; mi < 4; ++mi)
#pragma unroll
      for (int ni = 0; ni < 4; ++ni) {
        const int L = (mi * 4 + ni) * 4;
        u32x2 v = {cvtpk(acc[2 * hh + (L >> 5)][(L >> 4) & 1][L & 15], acc[2 * hh + (L >> 5)][(L >> 4) & 1][(L & 15) + 1]),
                   cvtpk(acc[2 * hh + (L >> 5)][(L >> 4) & 1][(L & 15) + 2], acc[2 * hh + (L >> 5)][(L >> 4) & 1][(L & 15) + 3])};
        *(u32x2*)(lds + (wn * 64 + ni * 16 + fr) * 528 + (hh * 128 + wm * 64 + mi * 16 + fq * 4) * 2) = v;
      }
  lds_barrier();
#pragma unroll
  for (int i = 0; i < 16; ++i) {
    const int e = tid + 256 * i, nl = e >> 5, mc = e & 31;
    u32x4 v = *(const u32x4*)(lds + nl * 528 + mc * 16);
    epi(n0 + nl, m0 + mc * 8, v);
  }
}

template <class Epi>
DI void run_gemm(const bf16_t* A, int lda, int MT, const bf16_t* B, int ldb, int NT, int K, bool fast_m, int& tiles_before, char* lds, const Epi& epi) {
  const int nslot = gridDim.x >> 3, xcd = blockIdx.x & 7, slot = blockIdx.x >> 3;
  const int big = fast_m ? NT : MT, small = fast_m ? MT : NT;
  const int nbig = (big - xcd + 7) >> 3;
  const int total = nbig * small;
  const int start = (slot + nslot - (tiles_before % nslot)) % nslot;
  bool pf = false;
  for (int i = start; i < total; i += nslot) {
    const int k = i / small, sm = i - k * small, bigt = xcd + 8 * k;
    const int mt = fast_m ? sm : bigt, nt = fast_m ? bigt : sm;
    const bf16_t *nA = nullptr, *nB = nullptr;
    if (i + nslot < total) {
      const int i2 = i + nslot, k2 = i2 / small, sm2 = i2 - k2 * small, bigt2 = xcd + 8 * k2;
      const int mt2 = fast_m ? sm2 : bigt2, nt2 = fast_m ? bigt2 : sm2;
      nA = A + (size_t)mt2 * 128 * lda; nB = B + (size_t)nt2 * 128 * ldb;
    }
    f32x16 acc[2][2];
    zero_acc(acc);
    pf = gemm_tile(acc, A + (size_t)mt * 128 * lda, lda, B + (size_t)nt * 128 * ldb, ldb, K, lds, pf, nA, lda, nB, ldb);
    store_tile16(acc, mt * 128, nt * 128, lds, epi);
  }
  tiles_before += ((big + 7) >> 3) * small;
}

DI void gemm_stage_big(const bf16_t* A, int lda, const bf16_t* B, int ldb, char* buf, int tid_) {
  int tid = tid_;
  asm volatile("" : "+v"(tid));
#pragma unroll
  for (int i = 0; i < 4; ++i) {
    const int p = tid + 256 * i, row = p >> 2, lc = (p & 3) ^ ((-(row >> 2)) & 3);
    const unsigned oa = (unsigned)(row * lda + lc * 8) * 2u;
    __builtin_amdgcn_global_load_lds((const unsigned*)((const char*)A + oa), (unsigned*)(buf + p * 16), 16, 0, 0);
  }
#pragma unroll
  for (int i = 0; i < 2; ++i) {
    const int p = tid + 256 * i, row = p >> 2, lc = (p & 3) ^ ((-(row >> 2)) & 3);
    const unsigned ob = (unsigned)(row * ldb + lc * 8) * 2u;
    __builtin_amdgcn_global_load_lds((const unsigned*)((const char*)B + ob), (unsigned*)(buf + 16384 + p * 16), 16, 0, 0);
  }
}
DI void gemm_tile_big(f32x16 (&acc)[4][2], const bf16_t* A, int lda, const bf16_t* B, int ldb, int K, char* lds) {
  const int tid = ltid(), lane = tid & 63, w = tid >> 6, wm = w >> 1, wn = w & 1, fr = lane & 15, fq = lane >> 4;
  const int co = (fq ^ ((-(fr >> 2)) & 3)) << 4;
  const int nk = K >> 5;
  f32x4m c[2][4][4];
#pragma unroll
  for (int hh = 0; hh < 2; ++hh)
#pragma unroll
    for (int mi = 0; mi < 4; ++mi)
#pragma unroll
      for (int ni = 0; ni < 4; ++ni)
#pragma unroll
        for (int j = 0; j < 4; ++j) { const int L = (mi * 4 + ni) * 4 + j; c[hh][mi][ni][j] = acc[2 * hh + (L >> 5)][(L >> 4) & 1][L & 15]; }
  __syncthreads();
  gemm_stage_big(A, lda, B, ldb, lds, tid);
  for (int kt = 0; kt < nk; ++kt) {
    asm volatile("s_waitcnt vmcnt(0)" ::: "memory");
    __syncthreads();
    if (kt + 1 < nk) gemm_stage_big(A + (kt + 1) * 32, lda, B + (kt + 1) * 32, ldb, lds + ((kt + 1) & 1) * 24576, tid);
    const char* As = lds + (kt & 1) * 24576;
    const char* Bs = As + 16384;
    bf16x8 af[2][4], bfr[4];
#pragma unroll
    for (int hh = 0; hh < 2; ++hh)
#pragma unroll
      for (int mi = 0; mi < 4; ++mi) af[hh][mi] = *(const bf16x8*)(As + (hh * 128 + wm * 64 + mi * 16 + fr) * 64 + co);
#pragma unroll
    for (int ni = 0; ni < 4; ++ni) bfr[ni] = *(const bf16x8*)(Bs + (wn * 64 + ni * 16 + fr) * 64 + co);
    __builtin_amdgcn_s_setprio(1);
#pragma unroll
    for (int hh = 0; hh < 2; ++hh)
#pragma unroll
      for (int mi = 0; mi < 4; ++mi)
#pragma unroll
        for (int ni = 0; ni < 4; ++ni) c[hh][mi][ni] = __builtin_amdgcn_mfma_f32_16x16x32_bf16(af[hh][mi], bfr[ni], c[hh][mi][ni], 0, 0, 0);
    __builtin_amdgcn_s_setprio(0);
  }
#pragma unroll
  for (int hh = 0; hh < 2; ++hh)
#pragma unroll
    for (int mi = 0; mi < 4; ++mi)
#pragma unroll
      for (int ni = 0; ni < 4; ++ni)
#pragma unroll
        for (int j = 0; j < 4; ++j) { const int L = (mi * 4 + ni) * 4 + j; acc[2 * hh + (L >> 5)][(L >> 4) & 1][L & 15] = c[hh][mi][ni][j]; }
}
template <class Epi>
DI void run_gemm_big(const bf16_t* A, int lda, int MT, const bf16_t* B, int ldb, int NT, int K, int& tiles_before, char* lds, const Epi& epi) {
  const int nslot = gridDim.x >> 3, xcd = blockIdx.x & 7, slot = blockIdx.x >> 3;
  const int nbig = (NT - xcd + 7) >> 3;
  const int total = nbig * MT;
  const int start = (slot + nslot - (tiles_before % nslot)) % nslot;
  for (int i = start; i < total; i += nslot) {
    const int k = i / MT, mt = i - k * MT, nt = xcd + 8 * k;
    f32x16 acc[4][2];
#pragma unroll
    for (int a = 0; a < 4; ++a)
#pragma unroll
      for (int b = 0; b < 2; ++b)
#pragma unroll
        for (int e = 0; e < 16; ++e) acc[a][b][e] = 0.f;
    gemm_tile_big(acc, A + (size_t)mt * 256 * lda, lda, B + (size_t)nt * 128 * ldb, ldb, K, lds);
    store_tile16_big(acc, mt * 256, nt * 128, lds, epi);
  }
  tiles_before += ((NT + 7) >> 3) * MT;
}

struct EpiRowMajor {
  bf16_t* out; int ld;
  DI void operator()(int n, int m, u32x4 v) const { *(u32x4*)(out + (size_t)n * ld + m) = v; }
};
struct EpiKmla {
  bf16_t* out;
  DI void operator()(int n, int m, u32x4 v) const {
    int b, key; tok2bk(n, b, key);
    *(u32x4*)(out + ((size_t)b * KV + key) * 384 + (m >> 6) * 96 + (m & 63)) = v;
  }
};
struct EpiVt2 {
  bf16_t *vtd, *vts;
  DI void operator()(int n, int m, u32x4 v) const {
    int b, key; tok2bk(m, b, key);
    bf16_t* dst = (n < 256) ? vtd + ((size_t)b * 256 + n) * KV + key : vts + ((size_t)b * 128 + (n - 256)) * KV + key;
    *(u32x4*)dst = v;
  }
};
struct EpiVtm {
  bf16_t* vt;
  DI void operator()(int n, int m, u32x4 v) const {
    int b, key; tok2bk(m, b, key);
    *(u32x4*)(vt + ((size_t)b * 256 + n) * KV + key) = v;
  }
};
struct EpiU {
  bf16_t* y;
  DI void operator()(int n, int m, u32x4 v) const {
    u32x4* py = (u32x4*)(y + (size_t)n * 1024 + m);
    float g[8], yy[8];
    unpack8(v, g); unpack8(*py, yy);
#pragma unroll
    for (int j = 0; j < 8; ++j) yy[j] = yy[j] * g[j] * sigmoidf_(g[j]);
    *py = pack8(yy);
  }
};

DI int win_srccol(int j) {
  if (j < 1120) return j;
  if (j < 1504) return j + 256;
  if (j < 1536) return -1;
  if (j < 1792) return j - 416;
  return j - 32;
}
DI void tr_tile(const float* src, int lds_, int col0, int k0, bf16_t* dst, int ldd, char* lds, float wscale = 1.f) {
  float* tl = (float*)lds;
  const int tid = ltid();
  __syncthreads();
  {
    const int col = tid & 31, kr = tid >> 5;
#pragma unroll
    for (int i = 0; i < 8; ++i) {
      int k = kr + 8 * i;
      tl[k * 33 + col] = (col0 >= 0) ? src[(size_t)(k0 + k) * lds_ + col0 + col] : 0.f;
    }
  }
  __syncthreads();
  {
    const int row = tid >> 3, kc = tid & 7;
    float f[8];
#pragma unroll
    for (int j = 0; j < 8; ++j) f[j] = tl[(kc * 8 + j) * 33 + row] * wscale;
    *(u32x4*)(dst + (size_t)row * ldd + k0 + kc * 8) = pack8(f);
  }
}

DI void phase0(const P& p, char* lds) {
  const int tid = ltid(), G = gridDim.x;
  constexpr int N_MOD = 96, N_MISC = 1, N_WPL = 16;
  constexpr int N_WIN = 2 * (WIN_ROWS / 32) * 16, N_WBR = 2 * 4 * 32 * 4, N_WOUT = 2 * 32 * 16, N_WUQ = 2 * 12 * 3, N_WUK = 2 * 8 * 2, N_WUV = 2 * 8 * 2;
  constexpr int B_MISC = N_MOD, B_WPL = B_MISC + N_MISC, B_WIN = B_WPL + N_WPL, B_WBR = B_WIN + N_WIN, B_WOUT = B_WBR + N_WBR, B_WUQ = B_WOUT + N_WOUT,
                B_WUK = B_WUQ + N_WUQ, B_WUV = B_WUK + N_WUK, N_ALL = B_WUV + N_WUV;
  for (int it = blockIdx.x; it < N_ALL; it += G) {
    if (it < B_MISC) {
      const int l = it / 48, nb = it % 48;
      float* sc = (float*)lds;
      float* red = sc + 9 * 1024;
      __syncthreads();
      for (int e = tid; e < 9 * 1024; e += 256) {
        int i = e >> 10, k = e & 1023;
        float v = (i < 8) ? p.c[i * 1024 + k] : p.cctx[k];
        sc[e] = v * sigmoidf_(v);
      }
      __syncthreads();
      const int w = tid >> 6, lane = tid & 63, n = nb * 64 + lane;
      float acc[9];
#pragma unroll
      for (int i = 0; i < 9; ++i) acc[i] = 0.f;
      const float* wp = p.w_mod + (size_t)l * 1024 * 3072 + (size_t)(w * 256) * 3072 + n;
      for (int k0 = 0; k0 < 256; k0 += 16) {
        float wv[16];
#pragma unroll
        for (int kk = 0; kk < 16; ++kk) wv[kk] = wp[(size_t)(k0 + kk) * 3072];
#pragma unroll
        for (int kk = 0; kk < 16; ++kk)
#pragma unroll
          for (int i = 0; i < 9; ++i) acc[i] += sc[i * 1024 + w * 256 + k0 + kk] * wv[kk];
      }
#pragma unroll
      for (int i = 0; i < 9; ++i) red[(w * 9 + i) * 64 + lane] = acc[i];
      __syncthreads();
      for (int e = tid; e < 9 * 64; e += 256) {
        int i = e >> 6, ln = e & 63;
        float s = red[(0 * 9 + i) * 64 + ln] + red[(1 * 9 + i) * 64 + ln] + red[(2 * 9 + i) * 64 + ln] + red[(3 * 9 + i) * 64 + ln];
        int nn = nb * 64 + ln;
        ((float*)(p.ws + OFF_MODV))[(l * 9 + i) * 3072 + nn] = s + p.b_mod[l * 3072 + nn];
      }
    } else if (it < B_WPL) {
      float2* t32 = (float2*)(p.ws + OFF_TR32);
      float2* t64 = (float2*)(p.ws + OFF_TR64);
      for (int e = tid; e < 128 * 8; e += 256) {
        int pp = e >> 3, i = e & 7;
        float f = expf(-9.210340371976184f * (float)i / 8.f);
        float a = (float)pp * f, s, c;
        sincosf(a, &s, &c);
        t32[e] = make_float2(c, s);
      }
      for (int e = tid; e < 128 * 16; e += 256) {
        int pp = e >> 4, i = e & 15;
        float f = expf(-9.210340371976184f * (float)i / 16.f);
        float a = (float)pp * f, s, c;
        sincosf(a, &s, &c);
        t64[e] = make_float2(c, s);
      }
      if (tid < 2) {
        int l = tid;
        float d1 = 0.f, d2 = 0.f;
        for (int i = 0; i < 32; ++i) { d1 += p.lq1[l * 32 + i] * p.lk1[l * 32 + i]; d2 += p.lq2[l * 32 + i] * p.lk2[l * 32 + i]; }
        float lam_init = 0.8f - 0.6f * expf(-0.3f * (float)l);
        float* lv = (float*)(p.ws + OFF_LAMV);
        lv[l * 2] = expf(d1) - expf(d2) + lam_init;
        lv[l * 2 + 1] = 1.f - lam_init;
      }
    } else if (it < B_WIN) {
      const int q = it - B_WPL, l = q >> 3, rb = q & 7;
      bf16_t* dst = (bf16_t*)(p.ws + OFF_WPL) + (size_t)l * 65536;
      for (int e = tid; e < 32 * 128; e += 256) {
        int n = rb * 32 + (e >> 7), k2 = (e & 127) * 2;
        float v[2];
#pragma unroll
        for (int j = 0; j < 2; ++j) {
          int k = k2 + j;
          v[j] = ((n >> 6) == (k >> 6)) ? p.w_pool[(size_t)l * 16384 + (n >> 6) * 4096 + (k & 63) * 64 + (n & 63)] * p.s_pool[l * 256 + n] : 0.f;
        }
        *(unsigned*)(dst + n * 256 + k2) = cvtpk(v[0], v[1]);
      }
    } else if (it < B_WBR) {
      const int q = it - B_WIN, l = q / (N_WIN / 2), r2 = q % (N_WIN / 2), rt = r2 >> 4, kt = r2 & 15;
      int sc0 = win_srccol(rt * 32);
      tr_tile(p.w_in + (size_t)l * 1024 * INC, INC, sc0, kt * 64, (bf16_t*)(p.ws + OFF_WINT) + ((size_t)l * WIN_ROWS + rt * 32) * 1024, 1024, lds);
    } else if (it < B_WOUT) {
      const int q = it - B_WBR, lr = q >> 7, r2 = q & 127, rt = r2 >> 2, kt = r2 & 3;
      tr_tile(p.w_br + (size_t)lr * 256 * 1024, 1024, rt * 32, kt * 64, (bf16_t*)(p.ws + OFF_WBRT) + ((size_t)lr * 1024 + rt * 32) * 256, 256, lds);
    } else if (it < B_WUQ) {
      const int q = it - B_WOUT, l = q >> 9, r2 = q & 511, rt = r2 >> 4, kt = r2 & 15;
      tr_tile(p.w_out + (size_t)l * 1024 * 1024, 1024, rt * 32, kt * 64, (bf16_t*)(p.ws + OFF_WOUT) + ((size_t)l * 1024 + rt * 32) * 1024, 1024, lds);
    } else if (it < B_WUK) {
      const int q = it - B_WUQ, l = q / 36, r2 = q % 36, rt = r2 / 3, kt = r2 % 3;
      tr_tile(p.w_uq + (size_t)l * 192 * 384, 384, rt * 32, kt * 64, (bf16_t*)(p.ws + OFF_WUQT) + ((size_t)l * 384 + rt * 32) * 192, 192, lds, 0.10206207261596575f * LOG2E);
    } else if (it < B_WUV) {
      const int q = it - B_WUK, l = q >> 4, r2 = q & 15, rt = r2 >> 1, kt = r2 & 1;
      tr_tile(p.w_uk + (size_t)l * 128 * 256, 256, rt * 32, kt * 64, (bf16_t*)(p.ws + OFF_WUKT) + ((size_t)l * 256 + rt * 32) * 128, 128, lds);
    } else {
      const int q = it - B_WUV, l = q >> 4, r2 = q & 15, rt = r2 >> 1, kt = r2 & 1;
      tr_tile(p.w_uv + (size_t)l * 128 * 256, 256, rt * 32, kt * 64, (bf16_t*)(p.ws + OFF_WUVT) + ((size_t)l * 256 + rt * 32) * 128, 128, lds);
    }
  }
}

DI void phase_modnorm(const P& p, int l) {
  const float* xl = (l == 0) ? p.x : p.out;
  const float* xc = (l == 0) ? p.ctx : (const float*)(p.ws + OFF_XC1);
  const float* modv = (const float*)(p.ws + OFF_MODV) + l * 9 * 3072;
  const float* gpre = p.g_pre + l * 1024;
  bf16_t* hb = (bf16_t*)(p.ws + OFF_H);
  const int tid = ltid(), lane = tid & 63, gw = blockIdx.x * 4 + (tid >> 6), nw = gridDim.x * 4;
  constexpr int NB = 4;
  for (int t0 = gw * NB; t0 < T; t0 += nw * NB) {
    const float* xr0; int mi;
    if (t0 < TL) { xr0 = xl + (size_t)t0 * 1024; mi = t0 >> 13; } else { xr0 = xc + (size_t)(t0 - TL) * 1024; mi = 8; }
    const float* mv = modv + mi * 3072;
    float4 v[NB][4];
#pragma unroll
    for (int u = 0; u < NB; ++u)
#pragma unroll
      for (int i = 0; i < 4; ++i) v[u][i] = *(const float4*)(xr0 + u * 1024 + lane * 4 + 256 * i);
    float rinv[NB];
#pragma unroll
    for (int u = 0; u < NB; ++u) {
      float ss = 0.f;
#pragma unroll
      for (int i = 0; i < 4; ++i) ss += v[u][i].x * v[u][i].x + v[u][i].y * v[u][i].y + v[u][i].z * v[u][i].z + v[u][i].w * v[u][i].w;
      ss = wave_sum(ss);
      rinv[u] = rsqrtf(ss * (1.f / 1024.f) + EPS);
    }
#pragma unroll
    for (int i = 0; i < 4; ++i) {
      const int col = lane * 4 + 256 * i;
      const float4 g = *(const float4*)(gpre + col), sh = *(const float4*)(mv + col), sc = *(const float4*)(mv + 1024 + col);
#pragma unroll
      for (int u = 0; u < NB; ++u) {
        const float o0 = v[u][i].x * rinv[u] * g.x * (1.f + sc.x) + sh.x, o1 = v[u][i].y * rinv[u] * g.y * (1.f + sc.y) + sh.y;
        const float o2 = v[u][i].z * rinv[u] * g.z * (1.f + sc.z) + sh.z, o3 = v[u][i].w * rinv[u] * g.w * (1.f + sc.w) + sh.w;
        const u32x2 o = {cvtpk(o0, o1), cvtpk(o2, o3)};
        *(u32x2*)(hb + (size_t)(t0 + u) * 1024 + col) = o;
      }
    }
  }
}

DI void phase_post(const P& p, int l) {
  const bf16_t* z1 = (const bf16_t*)(p.ws + OFF_Z1);
  bf16_t* cqn = (bf16_t*)(p.ws + OFF_CQN);
  bf16_t* ckvn = (bf16_t*)(p.ws + OFF_CKVN);
  bf16_t* pd = (bf16_t*)(p.ws + OFF_PD);
  bf16_t* km = (bf16_t*)(p.ws + OFF_KM);
  bf16_t* qd = (bf16_t*)(p.ws + OFF_QD);
  bf16_t* kd = (bf16_t*)(p.ws + OFF_KD);
  bf16_t* qs = (bf16_t*)(p.ws + OFF_QS);
  bf16_t* ks = (bf16_t*)(p.ws + OFF_KS);
  const float2* t32 = (const float2*)(p.ws + OFF_TR32);
  const float2* t64 = (const float2*)(p.ws + OFF_TR64);
  const float* gcq = p.g_cq + l * 192;
  const float* gckv = p.g_ckv + l * 128;
  const int tid = ltid(), lane = tid & 63, gw = blockIdx.x * 4 + (tid >> 6), nw = gridDim.x * 4;
  const int nl = lane < 40 ? lane : 0;
  const int q32 = lane & 31, e32 = q32 & 3, q1_32 = (e32 < 2) ? q32 : q32 - 2;
  const int base32 = (lane < 32) ? Z_DQ : Z_DK;
  const bool is64 = lane < 48;
  const int cbase = (lane < 32) ? Z_SQ : ((lane < 48) ? Z_SK : Z_KR);
  const int cq = (lane < 32) ? lane : ((lane < 48) ? lane - 32 : ((lane - 48) & 3));
  const int ce = is64 ? (cq & 7) : (cq & 3), chalf = is64 ? 4 : 2, cq1 = (ce < chalf) ? cq : cq - chalf;
  const int pq = lane & 31, hf = lane >> 5, wdw = 2 << (pq >> 3);
  struct PostLd { bool lat; int t, lo, hi; size_t kvr; u32x4 vn, a1, a2, c1, c2, selfv; float4 ta[4], tc[4]; float psum[8]; };
  auto ld_tok = [&](const int t, PostLd& L) {
    const bf16_t* zr = z1 + (size_t)t * ZW;
    const bool lat = t < TL; L.lat = lat; L.t = t;
    int b, key; tok2bk(t, b, key);
    const int pos = lat ? (t & (SEQ - 1)) : 0, prow = pos >> 6, pcol = pos & 63;
    const size_t kvr = (size_t)b * KV + key; L.kvr = kvr;
    L.vn = *(const u32x4*)(zr + Z_CQ + nl * 8);
    L.a1 = *(const u32x4*)(zr + base32 + q1_32 * 8); L.a2 = *(const u32x4*)(zr + base32 + (q1_32 + 2) * 8);
    L.c1 = *(const u32x4*)(zr + cbase + cq1 * 8); L.c2 = *(const u32x4*)(zr + cbase + (cq1 + chalf) * 8);
    const float4* tba = (const float4*)(t32 + ((e32 & 1) ? pcol : prow) * 8);
    const float4* tbc = is64 ? (const float4*)(t64 + (((ce & 3) >= 2) ? pcol : prow) * 16 + (ce & 1) * 8) : (const float4*)(t32 + ((ce & 1) ? pcol : prow) * 8);
#pragma unroll
    for (int j = 0; j < 4; ++j) { L.ta[j] = tba[j]; L.tc[j] = tbc[j]; }
    const int n = lat ? SEQ : CL, sp = lat ? (t & (SEQ - 1)) : key;
    const int lo = max(sp - wdw / 2, 0), hi = min(sp - wdw / 2 + wdw, n), mid = lo + ((hi - lo + 1) >> 1); L.lo = lo; L.hi = hi;
    const int mylo = hf ? mid : lo, myhi = hf ? hi : mid;
    const bf16_t* zb = z1 + (size_t)(t - sp) * ZW + Z_POOL + pq * 8;
    L.selfv = *(const u32x4*)(zb + (size_t)sp * ZW);
#pragma unroll
    for (int j = 0; j < 8; ++j) L.psum[j] = 0.f;
    for (int s2 = mylo; s2 < myhi; ++s2) {
      float v[8];
      unpack8(*(const u32x4*)(zb + (size_t)s2 * ZW), v);
#pragma unroll
      for (int j = 0; j < 8; ++j) L.psum[j] += v[j];
    }
  };
  auto do_tok = [&](PostLd& L) {
    {
      float v[8];
      unpack8(L.vn, v);
      float ss = 0.f;
#pragma unroll
      for (int j = 0; j < 8; ++j) ss += v[j] * v[j];
      const float s1 = wave_sum(lane < 24 ? ss : 0.f);
      const float s2 = wave_sum((lane >= 24 && lane < 40) ? ss : 0.f);
      if (lane < 24) {
        const float rinv = rsqrtf(s1 * (1.f / 192.f) + EPS);
#pragma unroll
        for (int j = 0; j < 8; ++j) v[j] = v[j] * rinv * gcq[lane * 8 + j];
        *(u32x4*)(cqn + (size_t)L.t * 192 + lane * 8) = pack8(v);
      } else if (lane < 40) {
        const float rinv = rsqrtf(s2 * (1.f / 128.f) + EPS);
#pragma unroll
        for (int j = 0; j < 8; ++j) v[j] = v[j] * rinv * gckv[(lane - 24) * 8 + j];
        *(u32x4*)(ckvn + (size_t)L.t * 128 + (lane - 24) * 8) = pack8(v);
      }
    }
    {
      float x1[8], x2[8], o[8];
      unpack8(L.a1, x1); unpack8(L.a2, x2);
      const float qsc = (lane < 32) ? 0.17677669529663687f * LOG2E : 1.f;
#pragma unroll
      for (int j = 0; j < 8; ++j) {
        const float cs = (j & 1) ? L.ta[j >> 1].z : L.ta[j >> 1].x, sn = (j & 1) ? L.ta[j >> 1].w : L.ta[j >> 1].y;
        const float rot = (e32 < 2) ? (x1[j] * cs - x2[j] * sn) : (x1[j] * sn + x2[j] * cs);
        const float raw = (e32 < 2) ? x1[j] : x2[j];
        o[j] = (L.lat ? rot : raw) * qsc;
      }
      const u32x4 ov = pack8(o);
      if (lane < 32) *(u32x4*)(qd + (size_t)L.t * 256 + q32 * 8) = ov;
      else *(u32x4*)(kd + L.kvr * 256 + q32 * 8) = ov;
    }
    {
      float x1[8], x2[8], o[8];
      unpack8(L.c1, x1); unpack8(L.c2, x2);
      const float qsc = (lane < 32) ? 0.125f * LOG2E : 1.f;
#pragma unroll
      for (int j = 0; j < 8; ++j) {
        const float cs = (j & 1) ? L.tc[j >> 1].z : L.tc[j >> 1].x, sn = (j & 1) ? L.tc[j >> 1].w : L.tc[j >> 1].y;
        const float rot = (ce < chalf) ? (x1[j] * cs - x2[j] * sn) : (x1[j] * sn + x2[j] * cs);
        const float raw = (ce < chalf) ? x1[j] : x2[j];
        o[j] = (L.lat ? rot : raw) * qsc;
      }
      const u32x4 ov = pack8(o);
      if (lane < 32) *(u32x4*)(qs + (size_t)L.t * 256 + cq * 8) = ov;
      else if (lane < 48) *(u32x4*)(ks + L.kvr * 128 + cq * 8) = ov;
      else if (lane < 52) {
#pragma unroll
        for (int hh = 0; hh < 4; ++hh) *(u32x4*)(km + L.kvr * 384 + hh * 96 + 64 + cq * 8) = ov;
      }
    }
    {
      float self[8];
      unpack8(L.selfv, self);
      const float inv = 1.f / (float)(L.hi - L.lo);
#pragma unroll
      for (int j = 0; j < 8; ++j) L.psum[j] = xhalf_sum(L.psum[j]) * inv - self[j];
      if (hf == 0) *(u32x4*)(pd + (size_t)L.t * 256 + pq * 8) = pack8(L.psum);
    }
  };
  for (int t = gw; t < T; t += 2 * nw) {
    PostLd A, B;
    ld_tok(t, A);
    const bool two = (t + nw) < T;
    if (two) ld_tok(t + nw, B);
    do_tok(A);
    if (two) do_tok(B);
  }
}

struct AttnArgs {
  const bf16_t* q[2]; int ldq;
  const bf16_t* k[2]; int ldk;
  const bf16_t* vt;
  int n1, k2, n2;
  int qpos0, rope;
  float c, sink_raw, lam, oscale;
  const float* gdiff;
  const float2* t32;
  bf16_t* y;
};

template <int DQK, int NMAP, bool SWA>
DI void attn_block(const AttnArgs& a, char* lds) {
  constexpr int KST = DQK + 8, NSTEP = DQK / 16, CPR = DQK / 8, KCH = (64 * CPR) / 256;
  constexpr int BUFE = NMAP * 64 * KST + 64 * 72;
  bf16_t* L0 = (bf16_t*)lds;
  const int tid = ltid(), lane = tid & 63, w = tid >> 6, r = lane & 31, h = lane >> 5;
  const int pr = (r & 0x13) | ((r & 4) << 1) | ((r & 8) >> 1);

  bf16x8 qf[NMAP][NSTEP];
#pragma unroll
  for (int m = 0; m < NMAP; ++m)
#pragma unroll
    for (int s = 0; s < NSTEP; ++s) qf[m][s] = *(const bf16x8*)(a.q[m] + (size_t)(w * 32 + r) * a.ldq + s * 16 + h * 8);
  if constexpr (DQK == 96) {
    if (a.rope) {
      const int pos = a.qpos0 + w * 32 + r;
      const float2* tb = a.t32 + (h ? (pos & 63) : (pos >> 6)) * 8;
      float x1[8], x2[8], o1[8], o2[8];
      unpack8(__builtin_bit_cast(u32x4, qf[0][4]), x1);
      unpack8(__builtin_bit_cast(u32x4, qf[0][5]), x2);
#pragma unroll
      for (int j = 0; j < 8; ++j) { float2 cs = tb[j]; o1[j] = x1[j] * cs.x - x2[j] * cs.y; o2[j] = x1[j] * cs.y + x2[j] * cs.x; }
      qf[0][4] = __builtin_bit_cast(bf16x8, pack8(o1));
      qf[0][5] = __builtin_bit_cast(bf16x8, pack8(o2));
    }
  }

  const int ntile = a.n1 + a.n2;
  u32x4 kr[NMAP][KCH], vr[2];
  auto load_into = [&](int t, u32x4 (&kk)[NMAP][KCH], u32x4 (&vv)[2]) {
    const int key0 = (t < a.n1) ? t * 64 : a.k2 + (t - a.n1) * 64;
#pragma unroll
    for (int m = 0; m < NMAP; ++m)
#pragma unroll
      for (int i = 0; i < KCH; ++i) {
        const int e = tid + 256 * i, row = e / CPR, kc = e % CPR;
        kk[m][i] = *(const u32x4*)(a.k[m] + (size_t)(key0 + row) * a.ldk + kc * 8);
      }
#pragma unroll
    for (int i = 0; i < 2; ++i) {
      const int e = tid + 256 * i, row = e >> 3, kc = e & 7;
      vv[i] = *(const u32x4*)(a.vt + (size_t)row * KV + key0 + kc * 8);
    }
  };
  auto write_from = [&](int buf, u32x4 (&kk)[NMAP][KCH], u32x4 (&vv)[2]) {
    bf16_t* Kb = L0 + buf * BUFE;
    bf16_t* Vb = Kb + NMAP * 64 * KST;
#pragma unroll
    for (int m = 0; m < NMAP; ++m)
#pragma unroll
      for (int i = 0; i < KCH; ++i) {
        const int e = tid + 256 * i, row = e / CPR, kc = e % CPR;
        *(u32x4*)(Kb + m * 64 * KST + row * KST + kc * 8) = kk[m][i];
      }
#pragma unroll
    for (int i = 0; i < 2; ++i) {
      const int e = tid + 256 * i, row = e >> 3, kc = e & 7;
      *(u32x4*)(Vb + row * 72 + kc * 8) = vv[i];
    }
  };
  auto load_tile = [&](int t) { load_into(t, kr, vr); };
  auto write_tile = [&](int buf) { write_from(buf, kr, vr); };

  f32x16 O[NMAP][2];
  float mref[NMAP], lrow[NMAP];
#pragma unroll
  for (int m = 0; m < NMAP; ++m) {
#pragma unroll
    for (int dt = 0; dt < 2; ++dt)
#pragma unroll
      for (int i = 0; i < 16; ++i) O[m][dt][i] = 0.f;
    mref[m] = 0.f;
    lrow[m] = (SWA && h == 0) ? __builtin_amdgcn_exp2f(a.sink_raw) : 0.f;
  }
  bool shifted[NMAP];
#pragma unroll
  for (int m = 0; m < NMAP; ++m) shifted[m] = false;
  const int qpos = a.qpos0 + w * 32 + r;

  auto qk = [&](f32x16& sx, const int m, const int buf, const int t, const int sub) {
    const bf16_t* Kc = L0 + buf * BUFE + m * 64 * KST + (sub * 32 + pr) * KST + h * 8;
    bf16x8 kf[NSTEP];
#pragma unroll
    for (int s = 0; s < NSTEP; ++s) kf[s] = *(const bf16x8*)(Kc + s * 16);
#pragma unroll
    for (int i = 0; i < 16; ++i) sx[i] = 0.f;
#pragma unroll
    for (int s = 0; s < NSTEP; ++s) sx = MFMA(kf[s], qf[m][s], sx);
    if constexpr (SWA) {
      if (t >= a.n1) {
        const int kb = a.k2 + (t - a.n1) * 64 - CL + 8 * h + sub * 32;
#pragma unroll
        for (int i = 0; i < 16; ++i) {
          const int dlt = qpos - (kb + 16 * (i >> 3) + (i & 7));
          if (dlt > 128 || dlt < -128) sx[i] = -1e30f;
        }
      }
    }
  };
  auto softmax_pv = [&](f32x16& sx, const int m, const int buf, const int sub, const int tcur,
                        f32x16& nx, const int nm, const int nbuf, const int nt, const int nsub) {
    const bf16_t* Vc = L0 + buf * BUFE + NMAP * 64 * KST + r * 72 + sub * 32 + h * 8;
    bf16x8 vf[2][2];
#pragma unroll
    for (int dt = 0; dt < 2; ++dt)
#pragma unroll
      for (int s2 = 0; s2 < 2; ++s2) vf[dt][s2] = *(const bf16x8*)(Vc + dt * 32 * 72 + s2 * 16);
    qk(nx, nm, nbuf, nt, nsub);
    f32v2 psa = {0.f, 0.f}, psb = {0.f, 0.f};
#pragma unroll
    for (int i = 0; i < 16; ++i) sx[i] = __builtin_amdgcn_exp2f(sx[i]);
#pragma unroll
    for (int i = 0; i < 4; ++i) {
      f32v2 t2 = {sx[4 * i], sx[4 * i + 1]}, t3 = {sx[4 * i + 2], sx[4 * i + 3]};
      psa += t2; psb += t3;
    }
    float ps = (psa[0] + psa[1]) + (psb[0] + psb[1]);
    asm volatile("" : "+v"(ps));
    __builtin_amdgcn_s_setprio(0);
    if (__builtin_expect(shifted[m] || !__all(ps <= 0x1p40f), 0)) {
      qk(sx, m, buf, tcur, sub);
      const float mr = mref[m];
#pragma unroll
      for (int i = 0; i < 16; ++i) sx[i] -= mr;
      float mx = fmaxf(sx[0], sx[1]);
#pragma unroll
      for (int i = 2; i < 16; ++i) mx = fmaxf(mx, sx[i]);
      mx = xhalf_max(mx);
      if (!__all(mx <= 30.f)) {
        const float d = fmaxf(mx, 0.f);
        const float alpha = __builtin_amdgcn_exp2f(-d);
        mref[m] += d;
        shifted[m] = true;
        lrow[m] *= alpha;
#pragma unroll
        for (int dt = 0; dt < 2; ++dt)
#pragma unroll
          for (int i = 0; i < 16; ++i) O[m][dt][i] *= alpha;
#pragma unroll
        for (int i = 0; i < 16; ++i) sx[i] -= d;
      }
      ps = 0.f;
#pragma unroll
      for (int i = 0; i < 16; ++i) { sx[i] = __builtin_amdgcn_exp2f(sx[i]); ps += sx[i]; }
    }
    __builtin_amdgcn_s_setprio(1);
    lrow[m] += ps;
    bf16x8 pf[2];
#pragma unroll
    for (int s2 = 0; s2 < 2; ++s2) {
      u32x4 pk = {cvtpk(sx[8 * s2 + 0], sx[8 * s2 + 1]), cvtpk(sx[8 * s2 + 2], sx[8 * s2 + 3]),
                  cvtpk(sx[8 * s2 + 4], sx[8 * s2 + 5]), cvtpk(sx[8 * s2 + 6], sx[8 * s2 + 7])};
      pf[s2] = __builtin_bit_cast(bf16x8, pk);
    }
#pragma unroll
    for (int s2 = 0; s2 < 2; ++s2)
#pragma unroll
      for (int dt = 0; dt < 2; ++dt) O[m][dt] = MFMA(vf[dt][s2], pf[s2], O[m][dt]);
    if constexpr (!SWA) {
      __builtin_amdgcn_sched_group_barrier(0x100, NSTEP + 4, 0);
      __builtin_amdgcn_sched_group_barrier(0x002, 9, 0);
#pragma unroll
      for (int s = 0; s < 4; ++s) {
        __builtin_amdgcn_sched_group_barrier(0x008, 1, 0);
        __builtin_amdgcn_sched_group_barrier(0x002, 3, 0);
      }
#pragma unroll
      for (int s = 0; s < NSTEP; ++s) {
        __builtin_amdgcn_sched_group_barrier(0x008, 1, 0);
        __builtin_amdgcn_sched_group_barrier(0x002, 4, 0);
      }
    }
  };

  {
    u32x4 k1[NMAP][KCH], v1[2];
    load_into(0, kr, vr);
    load_into(1, k1, v1);
    __syncthreads();
    write_from(0, kr, vr);
    if (ntile > 2) load_into(2, kr, vr);
    write_from(1, k1, v1);
  }
  __syncthreads();
  f32x16 sa, sb;
  qk(sa, 0, 0, 0, 0);
  int bc = 0;
#pragma unroll 1
  for (int tt = 0; tt < ntile; ++tt) {
    const int bn = (bc == 2) ? 0 : bc + 1, bw = (bn == 2) ? 0 : bn + 1;
    if (tt > 0) __syncthreads();
    if (tt + 2 < ntile) {
      write_tile(bw);
      if (tt + 3 < ntile) load_tile(tt + 3);
    }
    const bool last = (tt + 1 == ntile);
    const int xb = last ? bc : bn, xt = last ? tt : tt + 1;
    if constexpr (NMAP == 2) {
      softmax_pv(sa, 0, bc, 0, tt, sb, 1, bc, tt, 0);
      softmax_pv(sb, 1, bc, 0, tt, sa, 0, bc, tt, 1);
      softmax_pv(sa, 0, bc, 1, tt, sb, 1, bc, tt, 1);
      softmax_pv(sb, 1, bc, 1, tt, sa, 0, xb, xt, 0);
    } else {
      softmax_pv(sa, 0, bc, 0, tt, sb, 0, bc, tt, 1);
      softmax_pv(sb, 0, bc, 1, tt, sa, 0, xb, xt, 0);
    }
    bc = bn;
  }

  float inv[NMAP];
#pragma unroll
  for (int m = 0; m < NMAP; ++m) { float lt = xhalf_sum(lrow[m]); inv[m] = 1.f / lt; }
  bf16_t* yr = a.y + (size_t)(w * 32 + r) * 1024;
  if constexpr (NMAP == 1) {
#pragma unroll
    for (int dt = 0; dt < 2; ++dt)
#pragma unroll
      for (int g = 0; g < 4; ++g) {
        u32x2 v = {cvtpk(O[0][dt][4 * g] * inv[0], O[0][dt][4 * g + 1] * inv[0]), cvtpk(O[0][dt][4 * g + 2] * inv[0], O[0][dt][4 * g + 3] * inv[0])};
        *(u32x2*)(yr + dt * 32 + 8 * g + 4 * h) = v;
      }
  } else {
    float ss = 0.f;
    const float li = a.lam * inv[NMAP - 1];
#pragma unroll
    for (int dt = 0; dt < 2; ++dt)
#pragma unroll
      for (int i = 0; i < 16; ++i) { float o = O[0][dt][i] * inv[0] - O[NMAP - 1][dt][i] * li; O[0][dt][i] = o; ss += o * o; }
    ss = xhalf_sum(ss);
    const float rinv = rsqrtf(ss * (1.f / 64.f) + EPS) * a.oscale;
#pragma unroll
    for (int dt = 0; dt < 2; ++dt)
#pragma unroll
      for (int g = 0; g < 4; ++g) {
        const int d0 = dt * 32 + 8 * g + 4 * h;
        float4 gg = *(const float4*)(a.gdiff + d0);
        u32x2 v = {cvtpk(O[0][dt][4 * g] * rinv * gg.x, O[0][dt][4 * g + 1] * rinv * gg.y), cvtpk(O[0][dt][4 * g + 2] * rinv * gg.z, O[0][dt][4 * g + 3] * rinv * gg.w)};
        *(u32x2*)(yr + d0) = v;
      }
  }
}

DI void phase_attn(const P& p, int l, char* lds) {
  const bf16_t* qm = (const bf16_t*)(p.ws + OFF_QM);
  const bf16_t* km = (const bf16_t*)(p.ws + OFF_KM);
  const bf16_t* vtm = (const bf16_t*)(p.ws + OFF_VTM);
  const bf16_t* qd = (const bf16_t*)(p.ws + OFF_QD);
  const bf16_t* kd = (const bf16_t*)(p.ws + OFF_KD);
  const bf16_t* vtd = (const bf16_t*)(p.ws + OFF_VTD);
  const bf16_t* qs = (const bf16_t*)(p.ws + OFF_QS);
  const bf16_t* ks = (const bf16_t*)(p.ws + OFF_KS);
  const bf16_t* vts = (const bf16_t*)(p.ws + OFF_VTS);
  bf16_t* y = (bf16_t*)(p.ws + OFF_Y);
  const float* lv = (const float*)(p.ws + OFF_LAMV);
  const int nslot = gridDim.x >> 3, xcd = blockIdx.x & 7, slot = blockIdx.x >> 3;
  const int nitems = 768 + ((l == 0) ? 24 : 0);
  for (int li = slot; li < nitems; li += nslot) {
    int type, isctx = 0, pair, qb;
    if (li < 768) { type = li >> 8; if ((slot & 32) && type < 2) type ^= 1;
      const int i = li & 255; pair = xcd + 8 * (i >> 6); qb = i & 63; }
    else { const int j = li - 768; type = j >> 3; const int rr = j & 7; pair = xcd + 8 * (rr >> 1); qb = rr & 1; isctx = 1; }
    const int b = pair >> 2, hd = pair & 3;
    int qrow0, qpos0;
    if (!isctx) { qrow0 = b * SEQ + qb * 128; qpos0 = qb * 128; }
    else { qrow0 = TL + b * CL + qb * 128; qpos0 = 0; }
    AttnArgs a;
    a.t32 = (const float2*)(p.ws + OFF_TR32);
    a.qpos0 = qpos0; a.rope = 0; a.k2 = 0; a.n2 = 0; a.n1 = isctx ? 4 : (KV / 64);
    a.sink_raw = 0.f; a.lam = 0.f; a.oscale = 1.f; a.gdiff = p.g_diff + l * 64;
    if (type == 0) {
      a.q[0] = qd + (size_t)qrow0 * 256 + (2 * hd) * 32; a.q[1] = a.q[0] + 32; a.ldq = 256;
      a.k[0] = kd + (size_t)b * KV * 256 + (2 * hd) * 32; a.k[1] = a.k[0] + 32; a.ldk = 256;
      a.vt = vtd + ((size_t)b * 256 + hd * 64) * KV;
      a.c = 0.17677669529663687f * LOG2E;
      a.lam = lv[l * 2]; a.oscale = lv[l * 2 + 1];
      a.y = y + (size_t)qrow0 * 1024 + 512 + hd * 64;
      attn_block<32, 2, false>(a, lds);
    } else if (type == 1) {
      a.q[0] = qm + (size_t)qrow0 * 384 + hd * 96; a.q[1] = a.q[0]; a.ldq = 384;
      a.k[0] = km + (size_t)b * KV * 384 + hd * 96; a.k[1] = a.k[0]; a.ldk = 384;
      a.vt = vtm + ((size_t)b * 256 + hd * 64) * KV;
      a.c = 0.10206207261596575f * LOG2E;
      a.rope = isctx ? 0 : 1;
      a.y = y + (size_t)qrow0 * 1024 + 256 + hd * 64;
      attn_block<96, 1, false>(a, lds);
    } else {
      a.q[0] = qs + (size_t)qrow0 * 256 + hd * 64; a.q[1] = a.q[0]; a.ldq = 256;
      a.k[0] = ks + (size_t)b * KV * 128 + (hd >> 1) * 64; a.k[1] = a.k[0]; a.ldk = 128;
      a.vt = vts + ((size_t)b * 128 + (hd >> 1) * 64) * KV;
      a.c = 0.125f * LOG2E;
      a.sink_raw = p.sink[l * 4 + hd] * LOG2E;
      a.n1 = 4;
      if (!isctx) {
        const int wlo = max(0, (qb - 1) * 128), whi = min(SEQ, (qb + 2) * 128);
        a.k2 = CL + wlo; a.n2 = (whi - wlo) / 64;
      }
      a.y = y + (size_t)qrow0 * 1024 + 768 + hd * 64;
      attn_block<64, 1, true>(a, lds);
    }
  }
}

DI void phase_merge(const P& p, int l, int ntt, char* lds) {
  const bf16_t* wint = (const bf16_t*)(p.ws + OFF_WINT) + (size_t)l * WIN_ROWS * 1024;
  const bf16_t* wbrt = (const bf16_t*)(p.ws + OFF_WBRT) + (size_t)l * 4 * 1024 * 256;
  const bf16_t* hb = (const bf16_t*)(p.ws + OFF_H);
  const bf16_t* u = (const bf16_t*)(p.ws + OFF_Y);
  EpiRowMajor epi{(bf16_t*)(p.ws + OFF_MBUF), 1024};
  const int nslot = gridDim.x >> 3, xcd = blockIdx.x & 7, slot = blockIdx.x >> 3;
  const int total = ((ntt - xcd + 7) >> 3) * 8;
  bool pf = false;
  for (int t = slot; t < total; t += nslot) {
    const int mt = t & 7, nt = xcd + 8 * (t >> 3);
    const bf16_t* hB = hb + (size_t)nt * 128 * 1024;
    const bf16_t* uB = u + (size_t)nt * 128 * 1024;
    f32x16 macc[2][2];
    zero_acc(macc);
#pragma unroll 1
    for (int r = 0; r < 4; ++r) {
      unsigned sg[2][2][8];
      const bf16_t* wm_r = wint + (size_t)(WR_M + r * 1024 + mt * 128) * 1024;
      const bf16_t* wb_r = wbrt + (size_t)(r * 1024 + mt * 128) * 256;
      {
        f32x16 acc[2][2];
        zero_acc(acc);
        pf = gemm_tile(acc, wm_r, 1024, hB, 1024, 1024, lds, pf, wb_r, 256, uB + r * 256, 1024);
#pragma unroll
        for (int a = 0; a < 2; ++a)
#pragma unroll
          for (int b = 0; b < 2; ++b)
#pragma unroll
            for (int i = 0; i < 8; ++i) sg[a][b][i] = cvtpk(sigmoidf_(acc[a][b][2 * i]), sigmoidf_(acc[a][b][2 * i + 1]));
      }
      {
        const bf16_t *nA = nullptr, *nB = nullptr;
        if (r < 3) { nA = wint + (size_t)(WR_M + (r + 1) * 1024 + mt * 128) * 1024; nB = hB; }
        else if (t + nslot < total) {
          const int t2 = t + nslot, mt2 = t2 & 7, nt2 = xcd + 8 * (t2 >> 3);
          nA = wint + (size_t)(WR_M + mt2 * 128) * 1024; nB = hb + (size_t)nt2 * 128 * 1024;
        }
        f32x16 acc[2][2];
        zero_acc(acc);
        pf = gemm_tile(acc, wb_r, 256, uB + r * 256, 1024, 256, lds, pf, nA, 1024, nB, 1024);
#pragma unroll
        for (int a = 0; a < 2; ++a)
#pragma unroll
          for (int b = 0; b < 2; ++b)
#pragma unroll
            for (int i = 0; i < 8; ++i) {
              const unsigned sv = sg[a][b][i];
              macc[a][b][2 * i] += bflo(sv) * acc[a][b][2 * i];
              macc[a][b][2 * i + 1] += bfhi(sv) * acc[a][b][2 * i + 1];
            }
      }
    }
    store_tile16(macc, mt * 128, nt * 128, lds, epi);
  }
}

DI void phase_final(const P& p, int l) {
  const bf16_t* ob = (const bf16_t*)(p.ws + OFF_O);
  const float* modv = (const float*)(p.ws + OFF_MODV) + l * 9 * 3072;
  const float* gpost = p.g_post + l * 1024;
  const int ntok = (l == 0) ? T : TL;
  const int tid = ltid(), lane = tid & 63, gw = blockIdx.x * 4 + (tid >> 6), nw = gridDim.x * 4;
  constexpr int NB = 2;
  for (int t0 = gw * NB; t0 < ntok; t0 += nw * NB) {
    const float* xr0; float* xw0; int mi;
    if (t0 < TL) { xr0 = ((l == 0) ? p.x : (const float*)p.out) + (size_t)t0 * 1024; xw0 = p.out + (size_t)t0 * 1024; mi = t0 >> 13; }
    else { xr0 = p.ctx + (size_t)(t0 - TL) * 1024; xw0 = (float*)(p.ws + OFF_XC1) + (size_t)(t0 - TL) * 1024; mi = 8; }
    const float* gt = modv + mi * 3072 + 2048;
    u32x2 ov[NB][4];
    float4 xv[NB][4];
#pragma unroll
    for (int u = 0; u < NB; ++u)
#pragma unroll
      for (int i = 0; i < 4; ++i) {
        ov[u][i] = *(const u32x2*)(ob + (size_t)(t0 + u) * 1024 + lane * 4 + 256 * i);
        xv[u][i] = *(const float4*)(xr0 + u * 1024 + lane * 4 + 256 * i);
      }
    float o[NB][16], rinv[NB];
#pragma unroll
    for (int u = 0; u < NB; ++u) {
      float ss = 0.f;
#pragma unroll
      for (int i = 0; i < 4; ++i) {
        o[u][4 * i] = bflo(ov[u][i][0]); o[u][4 * i + 1] = bfhi(ov[u][i][0]); o[u][4 * i + 2] = bflo(ov[u][i][1]); o[u][4 * i + 3] = bfhi(ov[u][i][1]);
        ss += o[u][4 * i] * o[u][4 * i] + o[u][4 * i + 1] * o[u][4 * i + 1] + o[u][4 * i + 2] * o[u][4 * i + 2] + o[u][4 * i + 3] * o[u][4 * i + 3];
      }
      ss = wave_sum(ss);
      rinv[u] = rsqrtf(ss * (1.f / 1024.f) + EPS);
    }
#pragma unroll
    for (int i = 0; i < 4; ++i) {
      const int col = lane * 4 + 256 * i;
      const float4 g = *(const float4*)(gpost + col), gg = *(const float4*)(gt + col);
#pragma unroll
      for (int u = 0; u < NB; ++u) {
        float4 r4;
        r4.x = xv[u][i].x + gg.x * (o[u][4 * i] * rinv[u] * g.x);
        r4.y = xv[u][i].y + gg.y * (o[u][4 * i + 1] * rinv[u] * g.y);
        r4.z = xv[u][i].z + gg.z * (o[u][4 * i + 2] * rinv[u] * g.z);
        r4.w = xv[u][i].w + gg.w * (o[u][4 * i + 3] * rinv[u] * g.w);
        *(float4*)(xw0 + u * 1024 + col) = r4;
        o[u][4 * i] = r4.x; o[u][4 * i + 1] = r4.y; o[u][4 * i + 2] = r4.z; o[u][4 * i + 3] = r4.w;
      }
    }
    if (l == 0) {
      const float* mv2 = modv + 9 * 3072 + mi * 3072;
      const float* gpre2 = p.g_pre + 1024;
      bf16_t* hb = (bf16_t*)(p.ws + OFF_H);
      float rinv2[NB];
#pragma unroll
      for (int u = 0; u < NB; ++u) {
        float s2 = 0.f;
#pragma unroll
        for (int i = 0; i < 16; ++i) s2 += o[u][i] * o[u][i];
        s2 = wave_sum(s2);
        rinv2[u] = rsqrtf(s2 * (1.f / 1024.f) + EPS);
      }
#pragma unroll
      for (int i = 0; i < 4; ++i) {
        const int col = lane * 4 + 256 * i;
        const float4 g = *(const float4*)(gpre2 + col), sh = *(const float4*)(mv2 + col), sc = *(const float4*)(mv2 + 1024 + col);
#pragma unroll
        for (int u = 0; u < NB; ++u) {
          const float o0 = o[u][4 * i] * rinv2[u] * g.x * (1.f + sc.x) + sh.x, o1 = o[u][4 * i + 1] * rinv2[u] * g.y * (1.f + sc.y) + sh.y;
          const float o2 = o[u][4 * i + 2] * rinv2[u] * g.z * (1.f + sc.z) + sh.z, o3 = o[u][4 * i + 3] * rinv2[u] * g.w * (1.f + sc.w) + sh.w;
          const u32x2 hv = {cvtpk(o0, o1), cvtpk(o2, o3)};
          *(u32x2*)(hb + (size_t)(t0 + u) * 1024 + col) = hv;
        }
      }
    }
  }
}


#define XB_TMO      128
#define XB_XCNT(j)  (256  + 64 * (j))
#define XB_XSUB(j)  (1280 + 64 * (j))
#define XB_XGEN(j)  (2304 + 64 * (j))
#define XB_TOP      3328
#define XB_TOPGEN   3392
#define XCD_BAR_WORDS 3456
#define XB_SPIN_CAP (1u << 22)
#define LAS __attribute__((address_space(3)))
DI unsigned xb_ld(unsigned* p)              { return __hip_atomic_load(p, __ATOMIC_RELAXED, __HIP_MEMORY_SCOPE_AGENT); }
DI unsigned xb_add(unsigned* p, unsigned v) { return __hip_atomic_fetch_add(p, v, __ATOMIC_RELAXED, __HIP_MEMORY_SCOPE_AGENT); }
DI unsigned xb_xcc_id() { return (unsigned)__builtin_amdgcn_s_getreg((3 << 11) | 20) & 0xFu; }
#define XB_SPIN(cond, bar) do { unsigned _sp = 0; while (cond) { __builtin_amdgcn_s_sleep(1); \
    if ((++_sp & 255u) == 0u) { if (xb_ld(&(bar)[XB_TMO])) break; if (_sp > XB_SPIN_CAP) { atomicAdd(&(bar)[XB_TMO], 1u); break; } } } } while (0)
struct XcdBarrier { unsigned* bar; unsigned x; volatile LAS unsigned* st; };
DI XcdBarrier xcd_barrier_post(unsigned* bar, volatile LAS unsigned* st) {
  XcdBarrier b; b.bar = bar; b.x = xb_xcc_id(); b.st = st;
  if (threadIdx.x == 0) (void)xb_add(&bar[XB_XCNT(b.x)], 1u);
  return b;
}
DI void xcd_barrier_complete(unsigned* bar, unsigned x, unsigned& nloc, unsigned& nx) {
  const unsigned G = gridDim.x * gridDim.y * gridDim.z;
  unsigned sum, cnt, mine, sp = 0u;
  for (;;) {
    sum = 0u; cnt = 0u; mine = 0u;
#pragma unroll
    for (unsigned j = 0; j < 16; ++j) { const unsigned c = xb_ld(&bar[XB_XCNT(j)]); sum += c; cnt += (c > 0u) ? 1u : 0u; mine = (j == x) ? c : mine; }
    if (sum == G) break;
    __builtin_amdgcn_s_sleep(1);
    if ((++sp & 255u) == 0u) { if (xb_ld(&bar[XB_TMO])) break; if (sp > XB_SPIN_CAP) { atomicAdd(&bar[XB_TMO], 1u); break; } }
  }
  nloc = mine > 0u ? mine : 1u; nx = cnt > 0u ? cnt : 1u;
}
DI void xcd_barrier(const XcdBarrier& b) {
  asm volatile("s_waitcnt vmcnt(0)" ::: "memory");
  __syncthreads();
  if (threadIdx.x == 0) {
    unsigned* bar = b.bar;
    __builtin_amdgcn_s_waitcnt(0);
    unsigned nloc = b.st[0], nx = b.st[1];
    if (nloc == 0u) { xcd_barrier_complete(bar, b.x, nloc, nx); b.st[0] = nloc; b.st[1] = nx; }
    const unsigned old = xb_add(&bar[XB_XSUB(b.x)], 1u);
    const unsigned gen = old / nloc;
    if (old + 1u == (gen + 1u) * nloc) {
      __builtin_amdgcn_fence(__ATOMIC_RELEASE, "agent");
      asm volatile("s_waitcnt vmcnt(0)" ::: "memory");
      const unsigned og = xb_add(&bar[XB_TOP], 1u);
      const unsigned tg = og / nx;
      if (og + 1u == (tg + 1u) * nx) xb_add(&bar[XB_TOPGEN], 1u);
      else XB_SPIN(xb_ld(&bar[XB_TOPGEN]) == tg, bar);
      __builtin_amdgcn_fence(__ATOMIC_ACQUIRE, "agent");
      xb_add(&bar[XB_XGEN(b.x)], 1u);
      asm volatile("s_waitcnt vmcnt(0)" ::: "memory");
    } else {
      XB_SPIN(xb_ld(&bar[XB_XGEN(b.x)]) == gen, bar);
      __builtin_amdgcn_fence(__ATOMIC_ACQUIRE, "agent");
      asm volatile("s_waitcnt vmcnt(0)" ::: "memory");
    }
  }
  __syncthreads();
}

constexpr int NPHASE = 1 + 2 * 9;

DI void run_phase(const P& p, int ph, char* lds) {
  if (ph == 0) { phase0(p, lds); return; }
  const int l = (ph - 1) / 9, s = (ph - 1) % 9;
  const bf16_t* wint = (const bf16_t*)(p.ws + OFF_WINT) + (size_t)l * WIN_ROWS * 1024;
  bf16_t* hb = (bf16_t*)(p.ws + OFF_H);
  const int NTT = T / 128;
  const int NTC = (l == 0) ? T / 128 : TL / 128;
  int tb = 0;
  switch (s) {
    case 0: if (l == 0) phase_modnorm(p, l); break;
    case 1: {
      run_gemm_big(wint, 1024, ZW / 256, hb, 1024, TL / 128, 1024, tb, lds, EpiRowMajor{(bf16_t*)(p.ws + OFF_Z1), ZW});
      run_gemm(wint, 1024, ZW / 128, hb + (size_t)TL * 1024, 1024, TC / 128, 1024, true, tb, lds, EpiRowMajor{(bf16_t*)(p.ws + OFF_Z1) + (size_t)TL * ZW, ZW});
      run_gemm(hb, 1024, NTT, wint + (size_t)WR_J2 * 1024, 1024, 3, 1024, false, tb, lds, EpiVt2{(bf16_t*)(p.ws + OFF_VTD), (bf16_t*)(p.ws + OFF_VTS)});
    } break;
    case 2: phase_post(p, l); break;
    case 3: {
      run_gemm((const bf16_t*)(p.ws + OFF_WUQT) + (size_t)l * 384 * 192, 192, 3, (const bf16_t*)(p.ws + OFF_CQN), 192, NTT, 192, true, tb, lds,
               EpiRowMajor{(bf16_t*)(p.ws + OFF_QM), 384});
      run_gemm((const bf16_t*)(p.ws + OFF_WUKT) + (size_t)l * 256 * 128, 128, 2, (const bf16_t*)(p.ws + OFF_CKVN), 128, NTT, 128, true, tb, lds,
               EpiKmla{(bf16_t*)(p.ws + OFF_KM)});
      run_gemm((const bf16_t*)(p.ws + OFF_CKVN), 128, NTT, (const bf16_t*)(p.ws + OFF_WUVT) + (size_t)l * 256 * 128, 128, 2, 128, false, tb, lds,
               EpiVtm{(bf16_t*)(p.ws + OFF_VTM)});
      run_gemm((const bf16_t*)(p.ws + OFF_WPL) + (size_t)l * 65536, 256, 2, (const bf16_t*)(p.ws + OFF_PD), 256, NTC, 256, true, tb, lds,
               EpiRowMajor{(bf16_t*)(p.ws + OFF_Y), 1024});
    } break;
    case 4: phase_attn(p, l, lds); break;
    case 5: {
      run_gemm_big(wint + (size_t)WR_G * 1024, 1024, 4, hb, 1024, TL / 128, 1024, tb, lds, EpiU{(bf16_t*)(p.ws + OFF_Y)});
      if (l == 0) run_gemm(wint + (size_t)WR_G * 1024, 1024, 8, hb + (size_t)TL * 1024, 1024, TC / 128, 1024, true, tb, lds, EpiU{(bf16_t*)(p.ws + OFF_Y) + (size_t)TL * 1024});
    } break;
    case 6: phase_merge(p, l, NTC, lds); break;
    case 7: {
      const bf16_t* wo = (const bf16_t*)(p.ws + OFF_WOUT) + (size_t)l * 1024 * 1024;
      const bf16_t* mb = (const bf16_t*)(p.ws + OFF_MBUF);
      bf16_t* ob = (bf16_t*)(p.ws + OFF_O);
      run_gemm_big(wo, 1024, 4, mb, 1024, TL / 128, 1024, tb, lds, EpiRowMajor{ob, 1024});
      if (l == 0) run_gemm(wo, 1024, 8, mb + (size_t)TL * 1024, 1024, TC / 128, 1024, true, tb, lds, EpiRowMajor{ob + (size_t)TL * 1024, 1024});
    } break;
    case 8: phase_final(p, l); break;
  }
}

__global__ void __launch_bounds__(256, 2) mega(P p) {
  __shared__ __attribute__((aligned(16))) char lds[69632];
  cg::grid_group grid = cg::this_grid();
  volatile LAS unsigned* st = (volatile LAS unsigned*)(lds + 69616);
  if (threadIdx.x == 0) { st[0] = 0u; st[1] = 0u; }
  __syncthreads();
  XcdBarrier xb = xcd_barrier_post((unsigned*)(p.ws + OFF_BAR), st);
  for (int ph = p.phase_lo; ph < p.phase_hi; ++ph) {
    if (ph == 10) continue;
    if (ph > p.phase_lo) {
      if (p.phase_hi > 4096) grid.sync();
      xcd_barrier(xb);
    }
    run_phase(p, ph, lds);
  }
}

extern "C" void kernel_launch(void* const* d_in, const int* in_sizes, int n_in, void* d_out, int out_size, void* d_ws, size_t ws_size, hipStream_t stream) {
  static int grid = 0;
  if (grid == 0) {
    int dev = 0, cus = 0, per_cu = 0;
    hipGetDevice(&dev);
    hipDeviceGetAttribute(&cus, hipDeviceAttributeMultiprocessorCount, dev);
    hipOccupancyMaxActiveBlocksPerMultiprocessor(&per_cu, (const void*)mega, 256, 0);
    if (per_cu < 1) per_cu = 1;
    if (per_cu > 2) per_cu = 2;
    grid = cus * per_cu;
    if (ws_size < WS_END) { fprintf(stderr, "kernel_launch: workspace too small: %zu < %zu\n", ws_size, (size_t)WS_END); grid = -1; }
  }
  if (grid < 0) return;
  P p{};
  const float** f = (const float**)&p;
  for (int i = 0; i < 24; ++i) f[i] = (const float*)d_in[i];
  p.out = (float*)d_out;
  p.ws = (char*)d_ws;
#if SINGLE_LAUNCH
  if (hipMemsetAsync((char*)d_ws + OFF_BAR, 0, XCD_BAR_WORDS * 4, stream) != hipSuccess) { fprintf(stderr, "kernel_launch: memset of the barrier words failed\n"); return; }
  p.phase_lo = 0; p.phase_hi = NPHASE;
  void* args[] = {&p};
  hipError_t e = hipLaunchCooperativeKernel((const void*)mega, dim3(grid), dim3(256), args, 0, stream);
  if (e != hipSuccess) fprintf(stderr, "cooperative launch failed: %s (grid %d)\n", hipGetErrorString(e), grid);
#else
  for (int ph = 0; ph < NPHASE; ++ph) {
    p.phase_lo = ph; p.phase_hi = ph + 1;
    hipLaunchKernelGGL(mega, dim3(grid), dim3(256), 0, stream, p);
  }
#endif
}
```

```cpp
#include <hip/hip_runtime.h>
#include <hip/hip_cooperative_groups.h>
#include <stdint.h>
#include <stdio.h>
namespace cg = cooperative_groups;

#ifndef SINGLE_LAUNCH
#define SINGLE_LAUNCH 1
#endif

typedef unsigned short bf16_t;
using bf16x8 = __attribute__((ext_vector_type(8))) short;
using f32x16 = __attribute__((ext_vector_type(16))) float;
using u32x4  = __attribute__((ext_vector_type(4))) unsigned;
using u32x2  = __attribute__((ext_vector_type(2))) unsigned;
#define DI __device__ __forceinline__
#define MFMA(a, b, c) __builtin_amdgcn_mfma_f32_32x32x16_bf16((a), (b), (c), 0, 0, 0)

constexpr int DM = 1024, NBATCH = 8, SEQ = 8192, CL = 256;
constexpr int TL = NBATCH * SEQ;
constexpr int TC = NBATCH * CL;
constexpr int T  = TL + TC;
constexpr int KV = SEQ + CL;
constexpr int INC = 7008;
constexpr int ZW = 1536;
constexpr int Z_POOL = 0, Z_CQ = 256, Z_CKV = 448, Z_KR = 576, Z_DQ = 608, Z_DK = 864, Z_SQ = 1120, Z_SK = 1376;
constexpr int WIN_ROWS = 7040;
constexpr int WR_J2 = 1536, WR_G = 1920, WR_M = 2944;
constexpr float EPS = 1e-6f;
constexpr float LOG2E = 1.4426950408889634f;

constexpr size_t al(size_t x) { return (x + 255) & ~(size_t)255; }
constexpr size_t OFF_WINT = 0;
constexpr size_t OFF_WBRT = al(OFF_WINT + (size_t)2 * WIN_ROWS * 1024 * 2);
constexpr size_t OFF_WOUT = al(OFF_WBRT + (size_t)2 * 4 * 1024 * 256 * 2);
constexpr size_t OFF_WUQT = al(OFF_WOUT + (size_t)2 * 1024 * 1024 * 2);
constexpr size_t OFF_WUKT = al(OFF_WUQT + (size_t)2 * 384 * 192 * 2);
constexpr size_t OFF_WUVT = al(OFF_WUKT + (size_t)2 * 256 * 128 * 2);
constexpr size_t OFF_WPL  = al(OFF_WUVT + (size_t)2 * 256 * 128 * 2);
constexpr size_t OFF_MODV = al(OFF_WPL + (size_t)2 * 256 * 256 * 2);
constexpr size_t OFF_TR32 = al(OFF_MODV + (size_t)2 * 9 * 3072 * 4);
constexpr size_t OFF_TR64 = al(OFF_TR32 + (size_t)128 * 8 * 8);
constexpr size_t OFF_LAMV = al(OFF_TR64 + (size_t)128 * 16 * 8);
constexpr size_t OFF_XC1  = al(OFF_LAMV + 256);
constexpr size_t OFF_H    = al(OFF_XC1 + (size_t)TC * 1024 * 4);
constexpr size_t OFF_Z1   = al(OFF_H + (size_t)T * 1024 * 2);
constexpr size_t OFF_MBUF = OFF_Z1;
constexpr size_t OFF_CQN  = al(OFF_Z1 + (size_t)T * ZW * 2);
constexpr size_t OFF_CKVN = al(OFF_CQN + (size_t)T * 192 * 2);
constexpr size_t OFF_PD   = al(OFF_CKVN + (size_t)T * 128 * 2);
constexpr size_t OFF_QM   = al(OFF_PD + (size_t)T * 256 * 2);
constexpr size_t OFF_O    = OFF_QM;
constexpr size_t OFF_KM   = al(OFF_QM + (size_t)T * 384 * 2);
constexpr size_t OFF_VTM  = al(OFF_KM + (size_t)NBATCH * KV * 384 * 2);
constexpr size_t OFF_QD   = al(OFF_VTM + (size_t)NBATCH * 256 * KV * 2);
constexpr size_t OFF_KD   = al(OFF_QD + (size_t)T * 256 * 2);
constexpr size_t OFF_VTD  = al(OFF_KD + (size_t)NBATCH * KV * 256 * 2);
constexpr size_t OFF_QS   = al(OFF_VTD + (size_t)NBATCH * 256 * KV * 2);
constexpr size_t OFF_KS   = al(OFF_QS + (size_t)T * 256 * 2);
constexpr size_t OFF_VTS  = al(OFF_KS + (size_t)NBATCH * KV * 128 * 2);
constexpr size_t OFF_Y    = al(OFF_VTS + (size_t)NBATCH * 128 * KV * 2);
constexpr size_t OFF_BAR  = al(OFF_Y + (size_t)T * 1024 * 2);
constexpr size_t WS_END   = al(OFF_BAR + 16384);
static_assert(OFF_O + (size_t)T * 1024 * 2 <= OFF_QD, "o alias overflows");

struct P {
  const float *x, *c, *ctx, *cctx, *w_mod, *b_mod, *g_pre, *g_post, *w_in, *w_pool, *s_pool, *g_cq, *w_uq, *g_ckv, *w_uk, *w_uv;
  const float *lq1, *lk1, *lq2, *lk2, *g_diff, *sink, *w_br, *w_out;
  float* out;
  char* ws;
  int phase_lo, phase_hi;
};

typedef __bf16 bf16v2 __attribute__((ext_vector_type(2)));
typedef float f32v2 __attribute__((ext_vector_type(2)));
DI unsigned cvtpk(float lo, float hi) { f32v2 v = {lo, hi}; bf16v2 r = __builtin_convertvector(v, bf16v2); return __builtin_bit_cast(unsigned, r); }
DI float bflo(unsigned u) { return __uint_as_float(u << 16); }
DI float bfhi(unsigned u) { return __uint_as_float(u & 0xffff0000u); }
DI void unpack8(u32x4 v, float* f) {
#pragma unroll
  for (int i = 0; i < 4; ++i) { f[2 * i] = bflo(v[i]); f[2 * i + 1] = bfhi(v[i]); }
}
DI u32x4 pack8(const float* f) { u32x4 v = {cvtpk(f[0], f[1]), cvtpk(f[2], f[3]), cvtpk(f[4], f[5]), cvtpk(f[6], f[7])}; return v; }
DI float wave_sum(float v) {
#pragma unroll
  for (int o = 32; o > 0; o >>= 1) v += __shfl_xor(v, o);
  return v;
}
DI float xhalf_max(float v) { auto rr = __builtin_amdgcn_permlane32_swap(__float_as_uint(v), __float_as_uint(v), false, false); return fmaxf(__uint_as_float(rr[0]), __uint_as_float(rr[1])); }
DI float xhalf_sum(float v) { auto rr = __builtin_amdgcn_permlane32_swap(__float_as_uint(v), __float_as_uint(v), false, false); return __uint_as_float(rr[0]) + __uint_as_float(rr[1]); }
DI void tok2bk(int t, int& b, int& key) {
  if (t < TL) { b = t >> 13; key = CL + (t & (SEQ - 1)); } else { int u = t - TL; b = u >> 8; key = u & (CL - 1); }
}
DI int ltid() { int t = threadIdx.x; asm volatile("" : "+v"(t)); return t; }
DI float sigmoidf_(float x) { return __builtin_amdgcn_rcpf(1.f + __expf(-x)); }

DI void gemm_stage(const bf16_t* A, int lda, const bf16_t* B, int ldb, char* bufA, int tid_) {
  int tid = tid_;
  asm volatile("" : "+v"(tid));
#pragma unroll
  for (int i = 0; i < 4; ++i) {
    const int p = tid + 256 * i, row = p >> 3, lc = (p & 7) ^ ((row >> 1) & 7);
    const unsigned oa = (unsigned)(row * lda + lc * 8) * 2u, ob = (unsigned)(row * ldb + lc * 8) * 2u;
    __builtin_amdgcn_global_load_lds((const unsigned*)((const char*)A + oa), (unsigned*)(bufA + p * 16), 16, 0, 0);
    __builtin_amdgcn_global_load_lds((const unsigned*)((const char*)B + ob), (unsigned*)(bufA + 16384 + p * 16), 16, 0, 0);
  }
}
using f32x4m = __attribute__((ext_vector_type(4))) float;
DI bool gemm_tile(f32x16 (&acc)[2][2], const bf16_t* A, int lda, const bf16_t* B, int ldb, int K, char* lds, bool prefetched,
                  const bf16_t* nA, int nlda, const bf16_t* nB, int nldb) {
  const int tid = ltid(), lane = tid & 63, w = tid >> 6, wm = w >> 1, wn = w & 1, fr = lane & 15, fq = lane >> 4;
  const int sw = (fr >> 1) & 7;
  const int nk = K >> 6;
  const bool chain = (nA != nullptr) && ((nk & 1) == 0);
  f32x4m c[4][4];
#pragma unroll
  for (int mi = 0; mi < 4; ++mi)
#pragma unroll
    for (int ni = 0; ni < 4; ++ni)
#pragma unroll
      for (int j = 0; j < 4; ++j) { const int L = (mi * 4 + ni) * 4 + j; c[mi][ni][j] = acc[L >> 5][(L >> 4) & 1][L & 15]; }
  if (!prefetched) {
    __syncthreads();
    gemm_stage(A, lda, B, ldb, lds + 34816, tid);
  }
  for (int kt = 0; kt < nk; ++kt) {
    asm volatile("s_waitcnt vmcnt(0)" ::: "memory");
    __syncthreads();
    if (kt + 1 < nk) gemm_stage(A + (kt + 1) * 64, lda, B + (kt + 1) * 64, ldb, lds + (((kt + 1) & 1) ? 0 : 34816), tid);
    else if (chain) gemm_stage(nA, nlda, nB, nldb, lds + 34816, tid);
    const char* As = lds + ((kt & 1) ? 0 : 34816);
    const char* Bs = As + 16384;
#pragma unroll
    for (int kk = 0; kk < 2; ++kk) {
      bf16x8 af[4], bfr[4];
      const int co = ((4 * kk + fq) ^ sw) << 4;
#pragma unroll
      for (int mi = 0; mi < 4; ++mi) af[mi] = *(const bf16x8*)(As + (wm * 64 + mi * 16 + fr) * 128 + co);
#pragma unroll
      for (int ni = 0; ni < 4; ++ni) bfr[ni] = *(const bf16x8*)(Bs + (wn * 64 + ni * 16 + fr) * 128 + co);
      __builtin_amdgcn_s_setprio(1);
#pragma unroll
      for (int mi = 0; mi < 4; ++mi)
#pragma unroll
        for (int ni = 0; ni < 4; ++ni) c[mi][ni] = __builtin_amdgcn_mfma_f32_16x16x32_bf16(af[mi], bfr[ni], c[mi][ni], 0, 0, 0);
      __builtin_amdgcn_s_setprio(0);
    }
  }
#pragma unroll
  for (int mi = 0; mi < 4; ++mi)
#pragma unroll
    for (int ni = 0; ni < 4; ++ni)
#pragma unroll
      for (int j = 0; j < 4; ++j) { const int L = (mi * 4 + ni) * 4 + j; acc[L >> 5][(L >> 4) & 1][L & 15] = c[mi][ni][j]; }
  return chain;
}

DI void zero_acc(f32x16 (&acc)[2][2]) {
#pragma unroll
  for (int a = 0; a < 2; ++a)
#pragma unroll
    for (int b = 0; b < 2; ++b)
#pragma unroll
      for (int i = 0; i < 16; ++i) acc[a][b][i] = 0.f;
}

DI void lds_barrier() { asm volatile("s_waitcnt lgkmcnt(0)" ::: "memory"); __builtin_amdgcn_s_barrier(); asm volatile("" ::: "memory"); }
template <class Epi>
DI void store_tile(f32x16 (&acc)[2][2], int m0, int n0, char* lds, const Epi& epi) {
  const int tid = ltid(), lane = tid & 63, w = tid >> 6, wm = w >> 1, wn = w & 1, r = lane & 31, h = lane >> 5;
  lds_barrier();
#pragma unroll
  for (int mi = 0; mi < 2; ++mi)
#pragma unroll
    for (int ni = 0; ni < 2; ++ni)
#pragma unroll
      for (int g = 0; g < 4; ++g) {
        u32x2 v = {cvtpk(acc[mi][ni][4 * g], acc[mi][ni][4 * g + 1]), cvtpk(acc[mi][ni][4 * g + 2], acc[mi][ni][4 * g + 3])};
        *(u32x2*)(lds + (wn * 64 + ni * 32 + r) * 272 + (wm * 64 + mi * 32 + 8 * g + 4 * h) * 2) = v;
      }
  lds_barrier();
#pragma unroll
  for (int i = 0; i < 8; ++i) {
    int e = tid + 256 * i, nl = e >> 4, mc = e & 15;
    u32x4 v = *(const u32x4*)(lds + nl * 272 + mc * 16);
    epi(n0 + nl, m0 + mc * 8, v);
  }
}

template <class Epi>
DI void store_tile16(f32x16 (&acc)[2][2], int m0, int n0, char* lds, const Epi& epi) {
  const int tid = ltid(), lane = tid & 63, w = tid >> 6, wm = w >> 1, wn = w & 1, fr = lane & 15, fq = lane >> 4;
  lds_barrier();
#pragma unroll
  for (int mi = 0; mi < 4; ++mi)
#pragma unroll
    for (int ni = 0; ni < 4; ++ni) {
      const int L = (mi * 4 + ni) * 4;
      u32x2 v = {cvtpk(acc[L >> 5][(L >> 4) & 1][L & 15], acc[L >> 5][(L >> 4) & 1][(L & 15) + 1]),
                 cvtpk(acc[L >> 5][(L >> 4) & 1][(L & 15) + 2], acc[L >> 5][(L >> 4) & 1][(L & 15) + 3])};
      *(u32x2*)(lds + (wn * 64 + ni * 16 + fr) * 272 + (wm * 64 + mi * 16 + fq * 4) * 2) = v;
    }
  lds_barrier();
#pragma unroll
  for (int i = 0; i < 8; ++i) {
    int e = tid + 256 * i, nl = e >> 4, mc = e & 15;
    u32x4 v = *(const u32x4*)(lds + nl * 272 + mc * 16);
    epi(n0 + nl, m0 + mc * 8, v);
  }
}

template <class Epi>
DI void run_gemm(const bf16_t* A, int lda, int MT, const bf16_t* B, int ldb, int NT, int K, bool fast_m, int& tiles_before, char* lds, const Epi& epi) {
  const int nslot = gridDim.x >> 3, xcd = blockIdx.x & 7, slot = blockIdx.x >> 3;
  const int big = fast_m ? NT : MT, small = fast_m ? MT : NT;
  const int nbig = (big - xcd + 7) >> 3;
  const int total = nbig * small;
  const int start = (slot + nslot - (tiles_before % nslot)) % nslot;
  bool pf = false;
  for (int i = start; i < total; i += nslot) {
    const int k = i / small, sm = i - k * small, bigt = xcd + 8 * k;
    const int mt = fast_m ? sm : bigt, nt = fast_m ? bigt : sm;
    const bf16_t *nA = nullptr, *nB = nullptr;
    if (i + nslot < total) {
      const int i2 = i + nslot, k2 = i2 / small, sm2 = i2 - k2 * small, bigt2 = xcd + 8 * k2;
      const int mt2 = fast_m ? sm2 : bigt2, nt2 = fast_m ? bigt2 : sm2;
      nA = A + (size_t)mt2 * 128 * lda; nB = B + (size_t)nt2 * 128 * ldb;
    }
    f32x16 acc[2][2];
    zero_acc(acc);
    pf = gemm_tile(acc, A + (size_t)mt * 128 * lda, lda, B + (size_t)nt * 128 * ldb, ldb, K, lds, pf, nA, lda, nB, ldb);
    store_tile16(acc, mt * 128, nt * 128, lds, epi);
  }
  tiles_before += ((big + 7) >> 3) * small;
}

DI void gemm_stage_big(const bf16_t* A, int lda, const bf16_t* B, int ldb, char* buf, int tid_) {
  int tid = tid_;
  asm volatile("" : "+v"(tid));
#pragma unroll
  for (int i = 0; i < 4; ++i) {
    const int p = tid + 256 * i, row = p >> 2, lc = (p & 3) ^ ((-(row >> 2)) & 3);
    const unsigned oa = (unsigned)(row * lda + lc * 8) * 2u;
    __builtin_amdgcn_global_load_lds((const unsigned*)((const char*)A + oa), (unsigned*)(buf + p * 16), 16, 0, 0);
  }
#pragma unroll
  for (int i = 0; i < 2; ++i) {
    const int p = tid + 256 * i, row = p >> 2, lc = (p & 3) ^ ((-(row >> 2)) & 3);
    const unsigned ob = (unsigned)(row * ldb + lc * 8) * 2u;
    __builtin_amdgcn_global_load_lds((const unsigned*)((const char*)B + ob), (unsigned*)(buf + 16384 + p * 16), 16, 0, 0);
  }
}
DI void gemm_tile_big(f32x16 (&acc)[4][2], const bf16_t* A, int lda, const bf16_t* B, int ldb, int K, char* lds) {
  const int tid = ltid(), lane = tid & 63, w = tid >> 6, wm = w >> 1, wn = w & 1, fr = lane & 15, fq = lane >> 4;
  const int co = (fq ^ ((-(fr >> 2)) & 3)) << 4;
  const int nk = K >> 5;
  f32x4m c[2][4][4];
#pragma unroll
  for (int hh = 0; hh < 2; ++hh)
#pragma unroll
    for (int mi = 0; mi < 4; ++mi)
#pragma unroll
      for (int ni = 0; ni < 4; ++ni)
#pragma unroll
        for (int j = 0; j < 4; ++j) { const int L = (mi * 4 + ni) * 4 + j; c[hh][mi][ni][j] = acc[2 * hh + (L >> 5)][(L >> 4) & 1][L & 15]; }
  __syncthreads();
  gemm_stage_big(A, lda, B, ldb, lds, tid);
  for (int kt = 0; kt < nk; ++kt) {
    asm volatile("s_waitcnt vmcnt(0)" ::: "memory");
    __syncthreads();
    if (kt + 1 < nk) gemm_stage_big(A + (kt + 1) * 32, lda, B + (kt + 1) * 32, ldb, lds + ((kt + 1) & 1) * 24576, tid);
    const char* As = lds + (kt & 1) * 24576;
    const char* Bs = As + 16384;
    bf16x8 af[2][4], bfr[4];
#pragma unroll
    for (int hh = 0; hh < 2; ++hh)
#pragma unroll
      for (int mi = 0; mi < 4; ++mi) af[hh][mi] = *(const bf16x8*)(As + (hh * 128 + wm * 64 + mi * 16 + fr) * 64 + co);
#pragma unroll
    for (int ni = 0; ni < 4; ++ni) bfr[ni] = *(const bf16x8*)(Bs + (wn * 64 + ni * 16 + fr) * 64 + co);
    __builtin_amdgcn_s_setprio(1);
#pragma unroll
    for (int hh = 0; hh < 2; ++hh)
#pragma unroll
      for (int mi = 0; mi < 4; ++mi)
#pragma unroll
        for (int ni = 0; ni < 4; ++ni) c[hh][mi][ni] = __builtin_amdgcn_mfma_f32_16x16x32_bf16(af[hh][mi], bfr[ni], c[hh][mi][ni], 0, 0, 0);
    __builtin_amdgcn_s_setprio(0);
  }
#pragma unroll
  for (int hh = 0; hh < 2; ++hh)
#pragma unroll
    for (int mi = 0; mi < 4; ++mi)
#pragma unroll
      for (int ni = 0; ni < 4; ++ni)
#pragma unroll
        for (int j = 0; j < 4; ++j) { const int L = (mi * 4 + ni) * 4 + j; acc[2 * hh + (L >> 5)][(L >> 4) & 1][L & 15] = c[hh][mi][ni][j]; }
}
template <class Epi>
DI void run_gemm_big(const bf16_t* A, int lda, int MT, const bf16_t* B, int ldb, int NT, int K, int& tiles_before, char* lds, const Epi& epi) {
  const int nslot = gridDim.x >> 3, xcd = blockIdx.x & 7, slot = blockIdx.x >> 3;
  const int nbig = (NT - xcd + 7) >> 3;
  const int total = nbig * MT;
  const int start = (slot + nslot - (tiles_before % nslot)) % nslot;
  for (int i = start; i < total; i += nslot) {
    const int k = i / MT, mt = i - k * MT, nt = xcd + 8 * k;
    f32x16 acc[4][2];
#pragma unroll
    for (int a = 0; a < 4; ++a)
#pragma unroll
      for (int b = 0; b < 2; ++b)
#pragma unroll
        for (int e = 0; e < 16; ++e) acc[a][b][e] = 0.f;
    gemm_tile_big(acc, A + (size_t)mt * 256 * lda, lda, B + (size_t)nt * 128 * ldb, ldb, K, lds);
    store_tile16(*(f32x16(*)[2][2])&acc[0], mt * 256, nt * 128, lds, epi);
    store_tile16(*(f32x16(*)[2][2])&acc[2], mt * 256 + 128, nt * 128, lds, epi);
  }
  tiles_before += ((NT + 7) >> 3) * MT;
}

struct EpiRowMajor {
  bf16_t* out; int ld;
  DI void operator()(int n, int m, u32x4 v) const { *(u32x4*)(out + (size_t)n * ld + m) = v; }
};
struct EpiKmla {
  bf16_t* out;
  DI void operator()(int n, int m, u32x4 v) const {
    int b, key; tok2bk(n, b, key);
    *(u32x4*)(out + ((size_t)b * KV + key) * 384 + (m >> 6) * 96 + (m & 63)) = v;
  }
};
struct EpiVt2 {
  bf16_t *vtd, *vts;
  DI void operator()(int n, int m, u32x4 v) const {
    int b, key; tok2bk(m, b, key);
    bf16_t* dst = (n < 256) ? vtd + ((size_t)b * 256 + n) * KV + key : vts + ((size_t)b * 128 + (n - 256)) * KV + key;
    *(u32x4*)dst = v;
  }
};
struct EpiVtm {
  bf16_t* vt;
  DI void operator()(int n, int m, u32x4 v) const {
    int b, key; tok2bk(m, b, key);
    *(u32x4*)(vt + ((size_t)b * 256 + n) * KV + key) = v;
  }
};
struct EpiU {
  bf16_t* y;
  DI void operator()(int n, int m, u32x4 v) const {
    u32x4* py = (u32x4*)(y + (size_t)n * 1024 + m);
    float g[8], yy[8];
    unpack8(v, g); unpack8(*py, yy);
#pragma unroll
    for (int j = 0; j < 8; ++j) yy[j] = yy[j] * g[j] * sigmoidf_(g[j]);
    *py = pack8(yy);
  }
};

DI int win_srccol(int j) {
  if (j < 1120) return j;
  if (j < 1504) return j + 256;
  if (j < 1536) return -1;
  if (j < 1792) return j - 416;
  return j - 32;
}
DI void tr_tile(const float* src, int lds_, int col0, int k0, bf16_t* dst, int ldd, char* lds, float wscale = 1.f) {
  float* tl = (float*)lds;
  const int tid = ltid();
  __syncthreads();
  {
    const int col = tid & 31, kr = tid >> 5;
#pragma unroll
    for (int i = 0; i < 8; ++i) {
      int k = kr + 8 * i;
      tl[k * 33 + col] = (col0 >= 0) ? src[(size_t)(k0 + k) * lds_ + col0 + col] : 0.f;
    }
  }
  __syncthreads();
  {
    const int row = tid >> 3, kc = tid & 7;
    float f[8];
#pragma unroll
    for (int j = 0; j < 8; ++j) f[j] = tl[(kc * 8 + j) * 33 + row] * wscale;
    *(u32x4*)(dst + (size_t)row * ldd + k0 + kc * 8) = pack8(f);
  }
}

DI void phase0(const P& p, char* lds) {
  const int tid = ltid(), G = gridDim.x;
  constexpr int N_MOD = 96, N_MISC = 1, N_WPL = 16;
  constexpr int N_WIN = 2 * (WIN_ROWS / 32) * 16, N_WBR = 2 * 4 * 32 * 4, N_WOUT = 2 * 32 * 16, N_WUQ = 2 * 12 * 3, N_WUK = 2 * 8 * 2, N_WUV = 2 * 8 * 2;
  constexpr int B_MISC = N_MOD, B_WPL = B_MISC + N_MISC, B_WIN = B_WPL + N_WPL, B_WBR = B_WIN + N_WIN, B_WOUT = B_WBR + N_WBR, B_WUQ = B_WOUT + N_WOUT,
                B_WUK = B_WUQ + N_WUQ, B_WUV = B_WUK + N_WUK, N_ALL = B_WUV + N_WUV;
  for (int it = blockIdx.x; it < N_ALL; it += G) {
    if (it < B_MISC) {
      const int l = it / 48, nb = it % 48;
      float* sc = (float*)lds;
      float* red = sc + 9 * 1024;
      __syncthreads();
      for (int e = tid; e < 9 * 1024; e += 256) {
        int i = e >> 10, k = e & 1023;
        float v = (i < 8) ? p.c[i * 1024 + k] : p.cctx[k];
        sc[e] = v * sigmoidf_(v);
      }
      __syncthreads();
      const int w = tid >> 6, lane = tid & 63, n = nb * 64 + lane;
      float acc[9];
#pragma unroll
      for (int i = 0; i < 9; ++i) acc[i] = 0.f;
      const float* wp = p.w_mod + (size_t)l * 1024 * 3072 + (size_t)(w * 256) * 3072 + n;
      for (int k0 = 0; k0 < 256; k0 += 16) {
        float wv[16];
#pragma unroll
        for (int kk = 0; kk < 16; ++kk) wv[kk] = wp[(size_t)(k0 + kk) * 3072];
#pragma unroll
        for (int kk = 0; kk < 16; ++kk)
#pragma unroll
          for (int i = 0; i < 9; ++i) acc[i] += sc[i * 1024 + w * 256 + k0 + kk] * wv[kk];
      }
#pragma unroll
      for (int i = 0; i < 9; ++i) red[(w * 9 + i) * 64 + lane] = acc[i];
      __syncthreads();
      for (int e = tid; e < 9 * 64; e += 256) {
        int i = e >> 6, ln = e & 63;
        float s = red[(0 * 9 + i) * 64 + ln] + red[(1 * 9 + i) * 64 + ln] + red[(2 * 9 + i) * 64 + ln] + red[(3 * 9 + i) * 64 + ln];
        int nn = nb * 64 + ln;
        ((float*)(p.ws + OFF_MODV))[(l * 9 + i) * 3072 + nn] = s + p.b_mod[l * 3072 + nn];
      }
    } else if (it < B_WPL) {
      float2* t32 = (float2*)(p.ws + OFF_TR32);
      float2* t64 = (float2*)(p.ws + OFF_TR64);
      for (int e = tid; e < 128 * 8; e += 256) {
        int pp = e >> 3, i = e & 7;
        float f = expf(-9.210340371976184f * (float)i / 8.f);
        float a = (float)pp * f, s, c;
        sincosf(a, &s, &c);
        t32[e] = make_float2(c, s);
      }
      for (int e = tid; e < 128 * 16; e += 256) {
        int pp = e >> 4, i = e & 15;
        float f = expf(-9.210340371976184f * (float)i / 16.f);
        float a = (float)pp * f, s, c;
        sincosf(a, &s, &c);
        t64[e] = make_float2(c, s);
      }
      if (tid < 2) {
        int l = tid;
        float d1 = 0.f, d2 = 0.f;
        for (int i = 0; i < 32; ++i) { d1 += p.lq1[l * 32 + i] * p.lk1[l * 32 + i]; d2 += p.lq2[l * 32 + i] * p.lk2[l * 32 + i]; }
        float lam_init = 0.8f - 0.6f * expf(-0.3f * (float)l);
        float* lv = (float*)(p.ws + OFF_LAMV);
        lv[l * 2] = expf(d1) - expf(d2) + lam_init;
        lv[l * 2 + 1] = 1.f - lam_init;
      }
    } else if (it < B_WIN) {
      const int q = it - B_WPL, l = q >> 3, rb = q & 7;
      bf16_t* dst = (bf16_t*)(p.ws + OFF_WPL) + (size_t)l * 65536;
      for (int e = tid; e < 32 * 128; e += 256) {
        int n = rb * 32 + (e >> 7), k2 = (e & 127) * 2;
        float v[2];
#pragma unroll
        for (int j = 0; j < 2; ++j) {
          int k = k2 + j;
          v[j] = ((n >> 6) == (k >> 6)) ? p.w_pool[(size_t)l * 16384 + (n >> 6) * 4096 + (k & 63) * 64 + (n & 63)] * p.s_pool[l * 256 + n] : 0.f;
        }
        *(unsigned*)(dst + n * 256 + k2) = cvtpk(v[0], v[1]);
      }
    } else if (it < B_WBR) {
      const int q = it - B_WIN, l = q / (N_WIN / 2), r2 = q % (N_WIN / 2), rt = r2 >> 4, kt = r2 & 15;
      int sc0 = win_srccol(rt * 32);
      tr_tile(p.w_in + (size_t)l * 1024 * INC, INC, sc0, kt * 64, (bf16_t*)(p.ws + OFF_WINT) + ((size_t)l * WIN_ROWS + rt * 32) * 1024, 1024, lds);
    } else if (it < B_WOUT) {
      const int q = it - B_WBR, lr = q >> 7, r2 = q & 127, rt = r2 >> 2, kt = r2 & 3;
      tr_tile(p.w_br + (size_t)lr * 256 * 1024, 1024, rt * 32, kt * 64, (bf16_t*)(p.ws + OFF_WBRT) + ((size_t)lr * 1024 + rt * 32) * 256, 256, lds);
    } else if (it < B_WUQ) {
      const int q = it - B_WOUT, l = q >> 9, r2 = q & 511, rt = r2 >> 4, kt = r2 & 15;
      tr_tile(p.w_out + (size_t)l * 1024 * 1024, 1024, rt * 32, kt * 64, (bf16_t*)(p.ws + OFF_WOUT) + ((size_t)l * 1024 + rt * 32) * 1024, 1024, lds);
    } else if (it < B_WUK) {
      const int q = it - B_WUQ, l = q / 36, r2 = q % 36, rt = r2 / 3, kt = r2 % 3;
      tr_tile(p.w_uq + (size_t)l * 192 * 384, 384, rt * 32, kt * 64, (bf16_t*)(p.ws + OFF_WUQT) + ((size_t)l * 384 + rt * 32) * 192, 192, lds, 0.10206207261596575f * LOG2E);
    } else if (it < B_WUV) {
      const int q = it - B_WUK, l = q >> 4, r2 = q & 15, rt = r2 >> 1, kt = r2 & 1;
      tr_tile(p.w_uk + (size_t)l * 128 * 256, 256, rt * 32, kt * 64, (bf16_t*)(p.ws + OFF_WUKT) + ((size_t)l * 256 + rt * 32) * 128, 128, lds);
    } else {
      const int q = it - B_WUV, l = q >> 4, r2 = q & 15, rt = r2 >> 1, kt = r2 & 1;
      tr_tile(p.w_uv + (size_t)l * 128 * 256, 256, rt * 32, kt * 64, (bf16_t*)(p.ws + OFF_WUVT) + ((size_t)l * 256 + rt * 32) * 128, 128, lds);
    }
  }
}

DI void phase_modnorm(const P& p, int l) {
  const float* xl = (l == 0) ? p.x : p.out;
  const float* xc = (l == 0) ? p.ctx : (const float*)(p.ws + OFF_XC1);
  const float* modv = (const float*)(p.ws + OFF_MODV) + l * 9 * 3072;
  const float* gpre = p.g_pre + l * 1024;
  bf16_t* hb = (bf16_t*)(p.ws + OFF_H);
  const int tid = ltid(), lane = tid & 63, gw = blockIdx.x * 4 + (tid >> 6), nw = gridDim.x * 4;
  constexpr int NB = 4;
  for (int t0 = gw * NB; t0 < T; t0 += nw * NB) {
    const float* xr0; int mi;
    if (t0 < TL) { xr0 = xl + (size_t)t0 * 1024; mi = t0 >> 13; } else { xr0 = xc + (size_t)(t0 - TL) * 1024; mi = 8; }
    const float* mv = modv + mi * 3072;
    float4 v[NB][4];
#pragma unroll
    for (int u = 0; u < NB; ++u)
#pragma unroll
      for (int i = 0; i < 4; ++i) v[u][i] = *(const float4*)(xr0 + u * 1024 + lane * 4 + 256 * i);
    float rinv[NB];
#pragma unroll
    for (int u = 0; u < NB; ++u) {
      float ss = 0.f;
#pragma unroll
      for (int i = 0; i < 4; ++i) ss += v[u][i].x * v[u][i].x + v[u][i].y * v[u][i].y + v[u][i].z * v[u][i].z + v[u][i].w * v[u][i].w;
      ss = wave_sum(ss);
      rinv[u] = rsqrtf(ss * (1.f / 1024.f) + EPS);
    }
#pragma unroll
    for (int i = 0; i < 4; ++i) {
      const int col = lane * 4 + 256 * i;
      const float4 g = *(const float4*)(gpre + col), sh = *(const float4*)(mv + col), sc = *(const float4*)(mv + 1024 + col);
#pragma unroll
      for (int u = 0; u < NB; ++u) {
        const float o0 = v[u][i].x * rinv[u] * g.x * (1.f + sc.x) + sh.x, o1 = v[u][i].y * rinv[u] * g.y * (1.f + sc.y) + sh.y;
        const float o2 = v[u][i].z * rinv[u] * g.z * (1.f + sc.z) + sh.z, o3 = v[u][i].w * rinv[u] * g.w * (1.f + sc.w) + sh.w;
        const u32x2 o = {cvtpk(o0, o1), cvtpk(o2, o3)};
        *(u32x2*)(hb + (size_t)(t0 + u) * 1024 + col) = o;
      }
    }
  }
}

DI void phase_post(const P& p, int l) {
  const bf16_t* z1 = (const bf16_t*)(p.ws + OFF_Z1);
  bf16_t* cqn = (bf16_t*)(p.ws + OFF_CQN);
  bf16_t* ckvn = (bf16_t*)(p.ws + OFF_CKVN);
  bf16_t* pd = (bf16_t*)(p.ws + OFF_PD);
  bf16_t* km = (bf16_t*)(p.ws + OFF_KM);
  bf16_t* qd = (bf16_t*)(p.ws + OFF_QD);
  bf16_t* kd = (bf16_t*)(p.ws + OFF_KD);
  bf16_t* qs = (bf16_t*)(p.ws + OFF_QS);
  bf16_t* ks = (bf16_t*)(p.ws + OFF_KS);
  const float2* t32 = (const float2*)(p.ws + OFF_TR32);
  const float2* t64 = (const float2*)(p.ws + OFF_TR64);
  const float* gcq = p.g_cq + l * 192;
  const float* gckv = p.g_ckv + l * 128;
  const int tid = ltid(), lane = tid & 63, gw = blockIdx.x * 4 + (tid >> 6), nw = gridDim.x * 4;
  const int nl = lane < 40 ? lane : 0;
  const int q32 = lane & 31, e32 = q32 & 3, q1_32 = (e32 < 2) ? q32 : q32 - 2;
  const int base32 = (lane < 32) ? Z_DQ : Z_DK;
  const bool is64 = lane < 48;
  const int cbase = (lane < 32) ? Z_SQ : ((lane < 48) ? Z_SK : Z_KR);
  const int cq = (lane < 32) ? lane : ((lane < 48) ? lane - 32 : ((lane - 48) & 3));
  const int ce = is64 ? (cq & 7) : (cq & 3), chalf = is64 ? 4 : 2, cq1 = (ce < chalf) ? cq : cq - chalf;
  const int pq = lane & 31, hf = lane >> 5, wdw = 2 << (pq >> 3);
  struct PostLd { bool lat; int t, lo, hi; size_t kvr; u32x4 vn, a1, a2, c1, c2, selfv; float4 ta[4], tc[4]; float psum[8]; };
  auto ld_tok = [&](const int t, PostLd& L) {
    const bf16_t* zr = z1 + (size_t)t * ZW;
    const bool lat = t < TL; L.lat = lat; L.t = t;
    int b, key; tok2bk(t, b, key);
    const int pos = lat ? (t & (SEQ - 1)) : 0, prow = pos >> 6, pcol = pos & 63;
    const size_t kvr = (size_t)b * KV + key; L.kvr = kvr;
    L.vn = *(const u32x4*)(zr + Z_CQ + nl * 8);
    L.a1 = *(const u32x4*)(zr + base32 + q1_32 * 8); L.a2 = *(const u32x4*)(zr + base32 + (q1_32 + 2) * 8);
    L.c1 = *(const u32x4*)(zr + cbase + cq1 * 8); L.c2 = *(const u32x4*)(zr + cbase + (cq1 + chalf) * 8);
    const float4* tba = (const float4*)(t32 + ((e32 & 1) ? pcol : prow) * 8);
    const float4* tbc = is64 ? (const float4*)(t64 + (((ce & 3) >= 2) ? pcol : prow) * 16 + (ce & 1) * 8) : (const float4*)(t32 + ((ce & 1) ? pcol : prow) * 8);
#pragma unroll
    for (int j = 0; j < 4; ++j) { L.ta[j] = tba[j]; L.tc[j] = tbc[j]; }
    const int n = lat ? SEQ : CL, sp = lat ? (t & (SEQ - 1)) : key;
    const int lo = max(sp - wdw / 2, 0), hi = min(sp - wdw / 2 + wdw, n), mid = lo + ((hi - lo + 1) >> 1); L.lo = lo; L.hi = hi;
    const int mylo = hf ? mid : lo, myhi = hf ? hi : mid;
    const bf16_t* zb = z1 + (size_t)(t - sp) * ZW + Z_POOL + pq * 8;
    L.selfv = *(const u32x4*)(zb + (size_t)sp * ZW);
#pragma unroll
    for (int j = 0; j < 8; ++j) L.psum[j] = 0.f;
    for (int s2 = mylo; s2 < myhi; ++s2) {
      float v[8];
      unpack8(*(const u32x4*)(zb + (size_t)s2 * ZW), v);
#pragma unroll
      for (int j = 0; j < 8; ++j) L.psum[j] += v[j];
    }
  };
  auto do_tok = [&](PostLd& L) {
    {
      float v[8];
      unpack8(L.vn, v);
      float ss = 0.f;
#pragma unroll
      for (int j = 0; j < 8; ++j) ss += v[j] * v[j];
      const float s1 = wave_sum(lane < 24 ? ss : 0.f);
      const float s2 = wave_sum((lane >= 24 && lane < 40) ? ss : 0.f);
      if (lane < 24) {
        const float rinv = rsqrtf(s1 * (1.f / 192.f) + EPS);
#pragma unroll
        for (int j = 0; j < 8; ++j) v[j] = v[j] * rinv * gcq[lane * 8 + j];
        *(u32x4*)(cqn + (size_t)L.t * 192 + lane * 8) = pack8(v);
      } else if (lane < 40) {
        const float rinv = rsqrtf(s2 * (1.f / 128.f) + EPS);
#pragma unroll
        for (int j = 0; j < 8; ++j) v[j] = v[j] * rinv * gckv[(lane - 24) * 8 + j];
        *(u32x4*)(ckvn + (size_t)L.t * 128 + (lane - 24) * 8) = pack8(v);
      }
    }
    {
      float x1[8], x2[8], o[8];
      unpack8(L.a1, x1); unpack8(L.a2, x2);
      const float qsc = (lane < 32) ? 0.17677669529663687f * LOG2E : 1.f;
#pragma unroll
      for (int j = 0; j < 8; ++j) {
        const float cs = (j & 1) ? L.ta[j >> 1].z : L.ta[j >> 1].x, sn = (j & 1) ? L.ta[j >> 1].w : L.ta[j >> 1].y;
        const float rot = (e32 < 2) ? (x1[j] * cs - x2[j] * sn) : (x1[j] * sn + x2[j] * cs);
        const float raw = (e32 < 2) ? x1[j] : x2[j];
        o[j] = (L.lat ? rot : raw) * qsc;
      }
      const u32x4 ov = pack8(o);
      if (lane < 32) *(u32x4*)(qd + (size_t)L.t * 256 + q32 * 8) = ov;
      else *(u32x4*)(kd + L.kvr * 256 + q32 * 8) = ov;
    }
    {
      float x1[8], x2[8], o[8];
      unpack8(L.c1, x1); unpack8(L.c2, x2);
      const float qsc = (lane < 32) ? 0.125f * LOG2E : 1.f;
#pragma unroll
      for (int j = 0; j < 8; ++j) {
        const float cs = (j & 1) ? L.tc[j >> 1].z : L.tc[j >> 1].x, sn = (j & 1) ? L.tc[j >> 1].w : L.tc[j >> 1].y;
        const float rot = (ce < chalf) ? (x1[j] * cs - x2[j] * sn) : (x1[j] * sn + x2[j] * cs);
        const float raw = (ce < chalf) ? x1[j] : x2[j];
        o[j] = (L.lat ? rot : raw) * qsc;
      }
      const u32x4 ov = pack8(o);
      if (lane < 32) *(u32x4*)(qs + (size_t)L.t * 256 + cq * 8) = ov;
      else if (lane < 48) *(u32x4*)(ks + L.kvr * 128 + cq * 8) = ov;
      else if (lane < 52) {
#pragma unroll
        for (int hh = 0; hh < 4; ++hh) *(u32x4*)(km + L.kvr * 384 + hh * 96 + 64 + cq * 8) = ov;
      }
    }
    {
      float self[8];
      unpack8(L.selfv, self);
      const float inv = 1.f / (float)(L.hi - L.lo);
#pragma unroll
      for (int j = 0; j < 8; ++j) L.psum[j] = xhalf_sum(L.psum[j]) * inv - self[j];
      if (hf == 0) *(u32x4*)(pd + (size_t)L.t * 256 + pq * 8) = pack8(L.psum);
    }
  };
  for (int t = gw; t < T; t += 2 * nw) {
    PostLd A, B;
    ld_tok(t, A);
    const bool two = (t + nw) < T;
    if (two) ld_tok(t + nw, B);
    do_tok(A);
    if (two) do_tok(B);
  }
}

struct AttnArgs {
  const bf16_t* q[2]; int ldq;
  const bf16_t* k[2]; int ldk;
  const bf16_t* vt;
  int n1, k2, n2;
  int qpos0, rope;
  float c, sink_raw, lam, oscale;
  const float* gdiff;
  const float2* t32;
  bf16_t* y;
};

template <int DQK, int NMAP, bool SWA>
DI void attn_block(const AttnArgs& a, char* lds) {
  constexpr int KST = DQK + 8, NSTEP = DQK / 16, CPR = DQK / 8, KCH = (64 * CPR) / 256;
  constexpr int BUFE = NMAP * 64 * KST + 64 * 72;
  bf16_t* L0 = (bf16_t*)lds;
  const int tid = ltid(), lane = tid & 63, w = tid >> 6, r = lane & 31, h = lane >> 5;
  const int pr = (r & 0x13) | ((r & 4) << 1) | ((r & 8) >> 1);

  bf16x8 qf[NMAP][NSTEP];
#pragma unroll
  for (int m = 0; m < NMAP; ++m)
#pragma unroll
    for (int s = 0; s < NSTEP; ++s) qf[m][s] = *(const bf16x8*)(a.q[m] + (size_t)(w * 32 + r) * a.ldq + s * 16 + h * 8);
  if constexpr (DQK == 96) {
    if (a.rope) {
      const int pos = a.qpos0 + w * 32 + r;
      const float2* tb = a.t32 + (h ? (pos & 63) : (pos >> 6)) * 8;
      float x1[8], x2[8], o1[8], o2[8];
      unpack8(__builtin_bit_cast(u32x4, qf[0][4]), x1);
      unpack8(__builtin_bit_cast(u32x4, qf[0][5]), x2);
#pragma unroll
      for (int j = 0; j < 8; ++j) { float2 cs = tb[j]; o1[j] = x1[j] * cs.x - x2[j] * cs.y; o2[j] = x1[j] * cs.y + x2[j] * cs.x; }
      qf[0][4] = __builtin_bit_cast(bf16x8, pack8(o1));
      qf[0][5] = __builtin_bit_cast(bf16x8, pack8(o2));
    }
  }

  const int ntile = a.n1 + a.n2;
  u32x4 kr[NMAP][KCH], vr[2];
  auto load_into = [&](int t, u32x4 (&kk)[NMAP][KCH], u32x4 (&vv)[2]) {
    const int key0 = (t < a.n1) ? t * 64 : a.k2 + (t - a.n1) * 64;
#pragma unroll
    for (int m = 0; m < NMAP; ++m)
#pragma unroll
      for (int i = 0; i < KCH; ++i) {
        const int e = tid + 256 * i, row = e / CPR, kc = e % CPR;
        kk[m][i] = *(const u32x4*)(a.k[m] + (size_t)(key0 + row) * a.ldk + kc * 8);
      }
#pragma unroll
    for (int i = 0; i < 2; ++i) {
      const int e = tid + 256 * i, row = e >> 3, kc = e & 7;
      vv[i] = *(const u32x4*)(a.vt + (size_t)row * KV + key0 + kc * 8);
    }
  };
  auto write_from = [&](int buf, u32x4 (&kk)[NMAP][KCH], u32x4 (&vv)[2]) {
    bf16_t* Kb = L0 + buf * BUFE;
    bf16_t* Vb = Kb + NMAP * 64 * KST;
#pragma unroll
    for (int m = 0; m < NMAP; ++m)
#pragma unroll
      for (int i = 0; i < KCH; ++i) {
        const int e = tid + 256 * i, row = e / CPR, kc = e % CPR;
        *(u32x4*)(Kb + m * 64 * KST + row * KST + kc * 8) = kk[m][i];
      }
#pragma unroll
    for (int i = 0; i < 2; ++i) {
      const int e = tid + 256 * i, row = e >> 3, kc = e & 7;
      *(u32x4*)(Vb + row * 72 + kc * 8) = vv[i];
    }
  };
  auto load_tile = [&](int t) { load_into(t, kr, vr); };
  auto write_tile = [&](int buf) { write_from(buf, kr, vr); };

  f32x16 O[NMAP][2];
  float mref[NMAP], lrow[NMAP];
#pragma unroll
  for (int m = 0; m < NMAP; ++m) {
#pragma unroll
    for (int dt = 0; dt < 2; ++dt)
#pragma unroll
      for (int i = 0; i < 16; ++i) O[m][dt][i] = 0.f;
    mref[m] = 0.f;
    lrow[m] = (SWA && h == 0) ? __builtin_amdgcn_exp2f(a.sink_raw) : 0.f;
  }
  bool shifted[NMAP];
#pragma unroll
  for (int m = 0; m < NMAP; ++m) shifted[m] = false;
  const int qpos = a.qpos0 + w * 32 + r;

  auto qk = [&](f32x16& sx, const int m, const int buf, const int t, const int sub) {
    const bf16_t* Kc = L0 + buf * BUFE + m * 64 * KST + (sub * 32 + pr) * KST + h * 8;
    bf16x8 kf[NSTEP];
#pragma unroll
    for (int s = 0; s < NSTEP; ++s) kf[s] = *(const bf16x8*)(Kc + s * 16);
#pragma unroll
    for (int i = 0; i < 16; ++i) sx[i] = 0.f;
#pragma unroll
    for (int s = 0; s < NSTEP; ++s) sx = MFMA(kf[s], qf[m][s], sx);
    if constexpr (SWA) {
      if (t >= a.n1) {
        const int kb = a.k2 + (t - a.n1) * 64 - CL + 8 * h + sub * 32;
#pragma unroll
        for (int i = 0; i < 16; ++i) {
          const int dlt = qpos - (kb + 16 * (i >> 3) + (i & 7));
          if (dlt > 128 || dlt < -128) sx[i] = -1e30f;
        }
      }
    }
  };
  bf16x8 vf[2][2];
  auto softmax_pv = [&](f32x16& sx, const int m, const int buf, const int sub, const int tcur,
                        f32x16& nx, const int nm, const int nbuf, const int nt, const int nsub) {
    const bf16_t* Vc = L0 + buf * BUFE + NMAP * 64 * KST + r * 72 + sub * 32 + h * 8;
    if (NMAP == 1 || m == 0) {
#pragma unroll
      for (int dt = 0; dt < 2; ++dt)
#pragma unroll
        for (int s2 = 0; s2 < 2; ++s2) vf[dt][s2] = *(const bf16x8*)(Vc + dt * 32 * 72 + s2 * 16);
    }
    qk(nx, nm, nbuf, nt, nsub);
    f32v2 psa = {0.f, 0.f}, psb = {0.f, 0.f};
#pragma unroll
    for (int i = 0; i < 16; ++i) sx[i] = __builtin_amdgcn_exp2f(sx[i]);
#pragma unroll
    for (int i = 0; i < 4; ++i) {
      f32v2 t2 = {sx[4 * i], sx[4 * i + 1]}, t3 = {sx[4 * i + 2], sx[4 * i + 3]};
      psa += t2; psb += t3;
    }
    float ps = (psa[0] + psa[1]) + (psb[0] + psb[1]);
    asm volatile("" : "+v"(ps));
    __builtin_amdgcn_s_setprio(0);
    if (__builtin_expect(shifted[m] || !__all(ps <= 0x1p40f), 0)) {
      qk(sx, m, buf, tcur, sub);
      const float mr = mref[m];
#pragma unroll
      for (int i = 0; i < 16; ++i) sx[i] -= mr;
      float mx = fmaxf(sx[0], sx[1]);
#pragma unroll
      for (int i = 2; i < 16; ++i) mx = fmaxf(mx, sx[i]);
      mx = xhalf_max(mx);
      if (!__all(mx <= 30.f)) {
        const float d = fmaxf(mx, 0.f);
        const float alpha = __builtin_amdgcn_exp2f(-d);
        mref[m] += d;
        shifted[m] = true;
        lrow[m] *= alpha;
#pragma unroll
        for (int dt = 0; dt < 2; ++dt)
#pragma unroll
          for (int i = 0; i < 16; ++i) O[m][dt][i] *= alpha;
#pragma unroll
        for (int i = 0; i < 16; ++i) sx[i] -= d;
      }
      ps = 0.f;
#pragma unroll
      for (int i = 0; i < 16; ++i) { sx[i] = __builtin_amdgcn_exp2f(sx[i]); ps += sx[i]; }
    }
    __builtin_amdgcn_s_setprio(1);
    lrow[m] += ps;
    bf16x8 pf[2];
#pragma unroll
    for (int s2 = 0; s2 < 2; ++s2) {
      u32x4 pk = {cvtpk(sx[8 * s2 + 0], sx[8 * s2 + 1]), cvtpk(sx[8 * s2 + 2], sx[8 * s2 + 3]),
                  cvtpk(sx[8 * s2 + 4], sx[8 * s2 + 5]), cvtpk(sx[8 * s2 + 6], sx[8 * s2 + 7])};
      pf[s2] = __builtin_bit_cast(bf16x8, pk);
    }
#pragma unroll
    for (int s2 = 0; s2 < 2; ++s2)
#pragma unroll
      for (int dt = 0; dt < 2; ++dt) O[m][dt] = MFMA(vf[dt][s2], pf[s2], O[m][dt]);
    if constexpr (!SWA) {
      __builtin_amdgcn_sched_group_barrier(0x100, NSTEP + 4, 0);
      __builtin_amdgcn_sched_group_barrier(0x002, 9, 0);
#pragma unroll
      for (int s = 0; s < 4; ++s) {
        __builtin_amdgcn_sched_group_barrier(0x008, 1, 0);
        __builtin_amdgcn_sched_group_barrier(0x002, 3, 0);
      }
#pragma unroll
      for (int s = 0; s < NSTEP; ++s) {
        __builtin_amdgcn_sched_group_barrier(0x008, 1, 0);
        __builtin_amdgcn_sched_group_barrier(0x002, 4, 0);
      }
    }
  };

  {
    u32x4 k1[NMAP][KCH], v1[2];
    load_into(0, kr, vr);
    load_into(1, k1, v1);
    __syncthreads();
    write_from(0, kr, vr);
    if (ntile > 2) load_into(2, kr, vr);
    write_from(1, k1, v1);
  }
  __syncthreads();
  f32x16 sa, sb;
  qk(sa, 0, 0, 0, 0);
  int bc = 0;
#pragma unroll 1
  for (int tt = 0; tt < ntile; ++tt) {
    const int bn = (bc == 2) ? 0 : bc + 1, bw = (bn == 2) ? 0 : bn + 1;
    if (tt > 0) __syncthreads();
    if (tt + 2 < ntile) {
      write_tile(bw);
      if (tt + 3 < ntile) load_tile(tt + 3);
    }
    const bool last = (tt + 1 == ntile);
    const int xb = last ? bc : bn, xt = last ? tt : tt + 1;
    if constexpr (NMAP == 2) {
      softmax_pv(sa, 0, bc, 0, tt, sb, 1, bc, tt, 0);
      softmax_pv(sb, 1, bc, 0, tt, sa, 0, bc, tt, 1);
      softmax_pv(sa, 0, bc, 1, tt, sb, 1, bc, tt, 1);
      softmax_pv(sb, 1, bc, 1, tt, sa, 0, xb, xt, 0);
    } else {
      softmax_pv(sa, 0, bc, 0, tt, sb, 0, bc, tt, 1);
      softmax_pv(sb, 0, bc, 1, tt, sa, 0, xb, xt, 0);
    }
    bc = bn;
  }

  float inv[NMAP];
#pragma unroll
  for (int m = 0; m < NMAP; ++m) { float lt = xhalf_sum(lrow[m]); inv[m] = 1.f / lt; }
  bf16_t* yr = a.y + (size_t)(w * 32 + r) * 1024;
  if constexpr (NMAP == 1) {
#pragma unroll
    for (int dt = 0; dt < 2; ++dt)
#pragma unroll
      for (int g = 0; g < 4; ++g) {
        u32x2 v = {cvtpk(O[0][dt][4 * g] * inv[0], O[0][dt][4 * g + 1] * inv[0]), cvtpk(O[0][dt][4 * g + 2] * inv[0], O[0][dt][4 * g + 3] * inv[0])};
        *(u32x2*)(yr + dt * 32 + 8 * g + 4 * h) = v;
      }
  } else {
    float ss = 0.f;
    const float li = a.lam * inv[NMAP - 1];
#pragma unroll
    for (int dt = 0; dt < 2; ++dt)
#pragma unroll
      for (int i = 0; i < 16; ++i) { float o = O[0][dt][i] * inv[0] - O[NMAP - 1][dt][i] * li; O[0][dt][i] = o; ss += o * o; }
    ss = xhalf_sum(ss);
    const float rinv = rsqrtf(ss * (1.f / 64.f) + EPS) * a.oscale;
#pragma unroll
    for (int dt = 0; dt < 2; ++dt)
#pragma unroll
      for (int g = 0; g < 4; ++g) {
        const int d0 = dt * 32 + 8 * g + 4 * h;
        float4 gg = *(const float4*)(a.gdiff + d0);
        u32x2 v = {cvtpk(O[0][dt][4 * g] * rinv * gg.x, O[0][dt][4 * g + 1] * rinv * gg.y), cvtpk(O[0][dt][4 * g + 2] * rinv * gg.z, O[0][dt][4 * g + 3] * rinv * gg.w)};
        *(u32x2*)(yr + d0) = v;
      }
  }
}

DI void phase_attn(const P& p, int l, char* lds) {
  const bf16_t* qm = (const bf16_t*)(p.ws + OFF_QM);
  const bf16_t* km = (const bf16_t*)(p.ws + OFF_KM);
  const bf16_t* vtm = (const bf16_t*)(p.ws + OFF_VTM);
  const bf16_t* qd = (const bf16_t*)(p.ws + OFF_QD);
  const bf16_t* kd = (const bf16_t*)(p.ws + OFF_KD);
  const bf16_t* vtd = (const bf16_t*)(p.ws + OFF_VTD);
  const bf16_t* qs = (const bf16_t*)(p.ws + OFF_QS);
  const bf16_t* ks = (const bf16_t*)(p.ws + OFF_KS);
  const bf16_t* vts = (const bf16_t*)(p.ws + OFF_VTS);
  bf16_t* y = (bf16_t*)(p.ws + OFF_Y);
  const float* lv = (const float*)(p.ws + OFF_LAMV);
  const int nslot = gridDim.x >> 3, xcd = blockIdx.x & 7, slot = blockIdx.x >> 3;
  const int nitems = 768 + ((l == 0) ? 24 : 0);
  for (int li = slot; li < nitems; li += nslot) {
    int type, isctx = 0, pair, qb;
    if (li < 768) { type = li >> 8; if ((slot & 32) && type < 2) type ^= 1;
      const int i = li & 255; pair = xcd + 8 * (i >> 6); qb = i & 63; }
    else { const int j = li - 768; type = j >> 3; const int rr = j & 7; pair = xcd + 8 * (rr >> 1); qb = rr & 1; isctx = 1; }
    const int b = pair >> 2, hd = pair & 3;
    int qrow0, qpos0;
    if (!isctx) { qrow0 = b * SEQ + qb * 128; qpos0 = qb * 128; }
    else { qrow0 = TL + b * CL + qb * 128; qpos0 = 0; }
    AttnArgs a;
    a.t32 = (const float2*)(p.ws + OFF_TR32);
    a.qpos0 = qpos0; a.rope = 0; a.k2 = 0; a.n2 = 0; a.n1 = isctx ? 4 : (KV / 64);
    a.sink_raw = 0.f; a.lam = 0.f; a.oscale = 1.f; a.gdiff = p.g_diff + l * 64;
    if (type == 0) {
      a.q[0] = qd + (size_t)qrow0 * 256 + (2 * hd) * 32; a.q[1] = a.q[0] + 32; a.ldq = 256;
      a.k[0] = kd + (size_t)b * KV * 256 + (2 * hd) * 32; a.k[1] = a.k[0] + 32; a.ldk = 256;
      a.vt = vtd + ((size_t)b * 256 + hd * 64) * KV;
      a.c = 0.17677669529663687f * LOG2E;
      a.lam = lv[l * 2]; a.oscale = lv[l * 2 + 1];
      a.y = y + (size_t)qrow0 * 1024 + 512 + hd * 64;
      attn_block<32, 2, false>(a, lds);
    } else if (type == 1) {
      a.q[0] = qm + (size_t)qrow0 * 384 + hd * 96; a.q[1] = a.q[0]; a.ldq = 384;
      a.k[0] = km + (size_t)b * KV * 384 + hd * 96; a.k[1] = a.k[0]; a.ldk = 384;
      a.vt = vtm + ((size_t)b * 256 + hd * 64) * KV;
      a.c = 0.10206207261596575f * LOG2E;
      a.rope = isctx ? 0 : 1;
      a.y = y + (size_t)qrow0 * 1024 + 256 + hd * 64;
      attn_block<96, 1, false>(a, lds);
    } else {
      a.q[0] = qs + (size_t)qrow0 * 256 + hd * 64; a.q[1] = a.q[0]; a.ldq = 256;
      a.k[0] = ks + (size_t)b * KV * 128 + (hd >> 1) * 64; a.k[1] = a.k[0]; a.ldk = 128;
      a.vt = vts + ((size_t)b * 128 + (hd >> 1) * 64) * KV;
      a.c = 0.125f * LOG2E;
      a.sink_raw = p.sink[l * 4 + hd] * LOG2E;
      a.n1 = 4;
      if (!isctx) {
        const int wlo = max(0, (qb - 1) * 128), whi = min(SEQ, (qb + 2) * 128);
        a.k2 = CL + wlo; a.n2 = (whi - wlo) / 64;
      }
      a.y = y + (size_t)qrow0 * 1024 + 768 + hd * 64;
      attn_block<64, 1, true>(a, lds);
    }
  }
}

DI void phase_merge(const P& p, int l, int ntt, char* lds) {
  const bf16_t* wint = (const bf16_t*)(p.ws + OFF_WINT) + (size_t)l * WIN_ROWS * 1024;
  const bf16_t* wbrt = (const bf16_t*)(p.ws + OFF_WBRT) + (size_t)l * 4 * 1024 * 256;
  const bf16_t* hb = (const bf16_t*)(p.ws + OFF_H);
  const bf16_t* u = (const bf16_t*)(p.ws + OFF_Y);
  EpiRowMajor epi{(bf16_t*)(p.ws + OFF_MBUF), 1024};
  const int nslot = gridDim.x >> 3, xcd = blockIdx.x & 7, slot = blockIdx.x >> 3;
  const int total = ((ntt - xcd + 7) >> 3) * 8;
  bool pf = false;
  for (int t = slot; t < total; t += nslot) {
    const int mt = t & 7, nt = xcd + 8 * (t >> 3);
    const bf16_t* hB = hb + (size_t)nt * 128 * 1024;
    const bf16_t* uB = u + (size_t)nt * 128 * 1024;
    f32x16 macc[2][2];
    zero_acc(macc);
#pragma unroll 1
    for (int r = 0; r < 4; ++r) {
      unsigned sg[2][2][8];
      const bf16_t* wm_r = wint + (size_t)(WR_M + r * 1024 + mt * 128) * 1024;
      const bf16_t* wb_r = wbrt + (size_t)(r * 1024 + mt * 128) * 256;
      {
        f32x16 acc[2][2];
        zero_acc(acc);
        pf = gemm_tile(acc, wm_r, 1024, hB, 1024, 1024, lds, pf, wb_r, 256, uB + r * 256, 1024);
#pragma unroll
        for (int a = 0; a < 2; ++a)
#pragma unroll
          for (int b = 0; b < 2; ++b)
#pragma unroll
            for (int i = 0; i < 8; ++i) sg[a][b][i] = cvtpk(sigmoidf_(acc[a][b][2 * i]), sigmoidf_(acc[a][b][2 * i + 1]));
      }
      {
        const bf16_t *nA = nullptr, *nB = nullptr;
        if (r < 3) { nA = wint + (size_t)(WR_M + (r + 1) * 1024 + mt * 128) * 1024; nB = hB; }
        else if (t + nslot < total) {
          const int t2 = t + nslot, mt2 = t2 & 7, nt2 = xcd + 8 * (t2 >> 3);
          nA = wint + (size_t)(WR_M + mt2 * 128) * 1024; nB = hb + (size_t)nt2 * 128 * 1024;
        }
        f32x16 acc[2][2];
        zero_acc(acc);
        pf = gemm_tile(acc, wb_r, 256, uB + r * 256, 1024, 256, lds, pf, nA, 1024, nB, 1024);
#pragma unroll
        for (int a = 0; a < 2; ++a)
#pragma unroll
          for (int b = 0; b < 2; ++b)
#pragma unroll
            for (int i = 0; i < 8; ++i) {
              const unsigned sv = sg[a][b][i];
              macc[a][b][2 * i] += bflo(sv) * acc[a][b][2 * i];
              macc[a][b][2 * i + 1] += bfhi(sv) * acc[a][b][2 * i + 1];
            }
      }
    }
    store_tile16(macc, mt * 128, nt * 128, lds, epi);
  }
}

DI void phase_final(const P& p, int l) {
  const bf16_t* ob = (const bf16_t*)(p.ws + OFF_O);
  const float* modv = (const float*)(p.ws + OFF_MODV) + l * 9 * 3072;
  const float* gpost = p.g_post + l * 1024;
  const int ntok = (l == 0) ? T : TL;
  const int tid = ltid(), lane = tid & 63, gw = blockIdx.x * 4 + (tid >> 6), nw = gridDim.x * 4;
  constexpr int NB = 2;
  for (int t0 = gw * NB; t0 < ntok; t0 += nw * NB) {
    const float* xr0; float* xw0; int mi;
    if (t0 < TL) { xr0 = ((l == 0) ? p.x : (const float*)p.out) + (size_t)t0 * 1024; xw0 = p.out + (size_t)t0 * 1024; mi = t0 >> 13; }
    else { xr0 = p.ctx + (size_t)(t0 - TL) * 1024; xw0 = (float*)(p.ws + OFF_XC1) + (size_t)(t0 - TL) * 1024; mi = 8; }
    const float* gt = modv + mi * 3072 + 2048;
    u32x2 ov[NB][4];
    float4 xv[NB][4];
#pragma unroll
    for (int u = 0; u < NB; ++u)
#pragma unroll
      for (int i = 0; i < 4; ++i) {
        ov[u][i] = *(const u32x2*)(ob + (size_t)(t0 + u) * 1024 + lane * 4 + 256 * i);
        xv[u][i] = *(const float4*)(xr0 + u * 1024 + lane * 4 + 256 * i);
      }
    float o[NB][16], rinv[NB];
#pragma unroll
    for (int u = 0; u < NB; ++u) {
      float ss = 0.f;
#pragma unroll
      for (int i = 0; i < 4; ++i) {
        o[u][4 * i] = bflo(ov[u][i][0]); o[u][4 * i + 1] = bfhi(ov[u][i][0]); o[u][4 * i + 2] = bflo(ov[u][i][1]); o[u][4 * i + 3] = bfhi(ov[u][i][1]);
        ss += o[u][4 * i] * o[u][4 * i] + o[u][4 * i + 1] * o[u][4 * i + 1] + o[u][4 * i + 2] * o[u][4 * i + 2] + o[u][4 * i + 3] * o[u][4 * i + 3];
      }
      ss = wave_sum(ss);
      rinv[u] = rsqrtf(ss * (1.f / 1024.f) + EPS);
    }
#pragma unroll
    for (int i = 0; i < 4; ++i) {
      const int col = lane * 4 + 256 * i;
      const float4 g = *(const float4*)(gpost + col), gg = *(const float4*)(gt + col);
#pragma unroll
      for (int u = 0; u < NB; ++u) {
        float4 r4;
        r4.x = xv[u][i].x + gg.x * (o[u][4 * i] * rinv[u] * g.x);
        r4.y = xv[u][i].y + gg.y * (o[u][4 * i + 1] * rinv[u] * g.y);
        r4.z = xv[u][i].z + gg.z * (o[u][4 * i + 2] * rinv[u] * g.z);
        r4.w = xv[u][i].w + gg.w * (o[u][4 * i + 3] * rinv[u] * g.w);
        *(float4*)(xw0 + u * 1024 + col) = r4;
        o[u][4 * i] = r4.x; o[u][4 * i + 1] = r4.y; o[u][4 * i + 2] = r4.z; o[u][4 * i + 3] = r4.w;
      }
    }
    if (l == 0) {
      const float* mv2 = modv + 9 * 3072 + mi * 3072;
      const float* gpre2 = p.g_pre + 1024;
      bf16_t* hb = (bf16_t*)(p.ws + OFF_H);
      float rinv2[NB];
#pragma unroll
      for (int u = 0; u < NB; ++u) {
        float s2 = 0.f;
#pragma unroll
        for (int i = 0; i < 16; ++i) s2 += o[u][i] * o[u][i];
        s2 = wave_sum(s2);
        rinv2[u] = rsqrtf(s2 * (1.f / 1024.f) + EPS);
      }
#pragma unroll
      for (int i = 0; i < 4; ++i) {
        const int col = lane * 4 + 256 * i;
        const float4 g = *(const float4*)(gpre2 + col), sh = *(const float4*)(mv2 + col), sc = *(const float4*)(mv2 + 1024 + col);
#pragma unroll
        for (int u = 0; u < NB; ++u) {
          const float o0 = o[u][4 * i] * rinv2[u] * g.x * (1.f + sc.x) + sh.x, o1 = o[u][4 * i + 1] * rinv2[u] * g.y * (1.f + sc.y) + sh.y;
          const float o2 = o[u][4 * i + 2] * rinv2[u] * g.z * (1.f + sc.z) + sh.z, o3 = o[u][4 * i + 3] * rinv2[u] * g.w * (1.f + sc.w) + sh.w;
          const u32x2 hv = {cvtpk(o0, o1), cvtpk(o2, o3)};
          *(u32x2*)(hb + (size_t)(t0 + u) * 1024 + col) = hv;
        }
      }
    }
  }
}


#define XB_TMO      128
#define XB_XCNT(j)  (256  + 64 * (j))
#define XB_XSUB(j)  (1280 + 64 * (j))
#define XB_XGEN(j)  (2304 + 64 * (j))
#define XB_TOP      3328
#define XB_TOPGEN   3392
#define XCD_BAR_WORDS 3456
#define XB_SPIN_CAP (1u << 22)
#define LAS __attribute__((address_space(3)))
DI unsigned xb_ld(unsigned* p)              { return __hip_atomic_load(p, __ATOMIC_RELAXED, __HIP_MEMORY_SCOPE_AGENT); }
DI unsigned xb_add(unsigned* p, unsigned v) { return __hip_atomic_fetch_add(p, v, __ATOMIC_RELAXED, __HIP_MEMORY_SCOPE_AGENT); }
DI unsigned xb_xcc_id() { return (unsigned)__builtin_amdgcn_s_getreg((3 << 11) | 20) & 0xFu; }
#define XB_SPIN(cond, bar) do { unsigned _sp = 0; while (cond) { __builtin_amdgcn_s_sleep(1); \
    if ((++_sp & 255u) == 0u) { if (xb_ld(&(bar)[XB_TMO])) break; if (_sp > XB_SPIN_CAP) { atomicAdd(&(bar)[XB_TMO], 1u); break; } } } } while (0)
struct XcdBarrier { unsigned* bar; unsigned x; volatile LAS unsigned* st; };
DI XcdBarrier xcd_barrier_post(unsigned* bar, volatile LAS unsigned* st) {
  XcdBarrier b; b.bar = bar; b.x = xb_xcc_id(); b.st = st;
  if (threadIdx.x == 0) (void)xb_add(&bar[XB_XCNT(b.x)], 1u);
  return b;
}
DI void xcd_barrier_complete(unsigned* bar, unsigned x, unsigned& nloc, unsigned& nx) {
  const unsigned G = gridDim.x * gridDim.y * gridDim.z;
  unsigned sum, cnt, mine, sp = 0u;
  for (;;) {
    sum = 0u; cnt = 0u; mine = 0u;
#pragma unroll
    for (unsigned j = 0; j < 16; ++j) { const unsigned c = xb_ld(&bar[XB_XCNT(j)]); sum += c; cnt += (c > 0u) ? 1u : 0u; mine = (j == x) ? c : mine; }
    if (sum == G) break;
    __builtin_amdgcn_s_sleep(1);
    if ((++sp & 255u) == 0u) { if (xb_ld(&bar[XB_TMO])) break; if (sp > XB_SPIN_CAP) { atomicAdd(&bar[XB_TMO], 1u); break; } }
  }
  nloc = mine > 0u ? mine : 1u; nx = cnt > 0u ? cnt : 1u;
}
DI void xcd_barrier(const XcdBarrier& b) {
  asm volatile("s_waitcnt vmcnt(0)" ::: "memory");
  __syncthreads();
  if (threadIdx.x == 0) {
    unsigned* bar = b.bar;
    __builtin_amdgcn_s_waitcnt(0);
    unsigned nloc = b.st[0], nx = b.st[1];
    if (nloc == 0u) { xcd_barrier_complete(bar, b.x, nloc, nx); b.st[0] = nloc; b.st[1] = nx; }
    const unsigned old = xb_add(&bar[XB_XSUB(b.x)], 1u);
    const unsigned gen = old / nloc;
    if (old + 1u == (gen + 1u) * nloc) {
      __builtin_amdgcn_fence(__ATOMIC_RELEASE, "agent");
      asm volatile("s_waitcnt vmcnt(0)" ::: "memory");
      const unsigned og = xb_add(&bar[XB_TOP], 1u);
      const unsigned tg = og / nx;
      if (og + 1u == (tg + 1u) * nx) xb_add(&bar[XB_TOPGEN], 1u);
      else XB_SPIN(xb_ld(&bar[XB_TOPGEN]) == tg, bar);
      __builtin_amdgcn_fence(__ATOMIC_ACQUIRE, "agent");
      xb_add(&bar[XB_XGEN(b.x)], 1u);
      asm volatile("s_waitcnt vmcnt(0)" ::: "memory");
    } else {
      XB_SPIN(xb_ld(&bar[XB_XGEN(b.x)]) == gen, bar);
      __builtin_amdgcn_fence(__ATOMIC_ACQUIRE, "agent");
      asm volatile("s_waitcnt vmcnt(0)" ::: "memory");
    }
  }
  __syncthreads();
}

constexpr int NPHASE = 1 + 2 * 9;

DI void run_phase(const P& p, int ph, char* lds) {
  if (ph == 0) { phase0(p, lds); return; }
  const int l = (ph - 1) / 9, s = (ph - 1) % 9;
  const bf16_t* wint = (const bf16_t*)(p.ws + OFF_WINT) + (size_t)l * WIN_ROWS * 1024;
  bf16_t* hb = (bf16_t*)(p.ws + OFF_H);
  const int NTT = T / 128;
  const int NTC = (l == 0) ? T / 128 : TL / 128;
  int tb = 0;
  switch (s) {
    case 0: if (l == 0) phase_modnorm(p, l); break;
    case 1: {
      run_gemm_big(wint, 1024, ZW / 256, hb, 1024, TL / 128, 1024, tb, lds, EpiRowMajor{(bf16_t*)(p.ws + OFF_Z1), ZW});
      run_gemm(wint, 1024, ZW / 128, hb + (size_t)TL * 1024, 1024, TC / 128, 1024, true, tb, lds, EpiRowMajor{(bf16_t*)(p.ws + OFF_Z1) + (size_t)TL * ZW, ZW});
      run_gemm(hb, 1024, NTT, wint + (size_t)WR_J2 * 1024, 1024, 3, 1024, false, tb, lds, EpiVt2{(bf16_t*)(p.ws + OFF_VTD), (bf16_t*)(p.ws + OFF_VTS)});
    } break;
    case 2: phase_post(p, l); break;
    case 3: {
      run_gemm((const bf16_t*)(p.ws + OFF_WUQT) + (size_t)l * 384 * 192, 192, 3, (const bf16_t*)(p.ws + OFF_CQN), 192, NTT, 192, true, tb, lds,
               EpiRowMajor{(bf16_t*)(p.ws + OFF_QM), 384});
      run_gemm((const bf16_t*)(p.ws + OFF_WUKT) + (size_t)l * 256 * 128, 128, 2, (const bf16_t*)(p.ws + OFF_CKVN), 128, NTT, 128, true, tb, lds,
               EpiKmla{(bf16_t*)(p.ws + OFF_KM)});
      run_gemm((const bf16_t*)(p.ws + OFF_CKVN), 128, NTT, (const bf16_t*)(p.ws + OFF_WUVT) + (size_t)l * 256 * 128, 128, 2, 128, false, tb, lds,
               EpiVtm{(bf16_t*)(p.ws + OFF_VTM)});
      run_gemm((const bf16_t*)(p.ws + OFF_WPL) + (size_t)l * 65536, 256, 2, (const bf16_t*)(p.ws + OFF_PD), 256, NTC, 256, true, tb, lds,
               EpiRowMajor{(bf16_t*)(p.ws + OFF_Y), 1024});
    } break;
    case 4: phase_attn(p, l, lds); break;
    case 5: {
      run_gemm_big(wint + (size_t)WR_G * 1024, 1024, 4, hb, 1024, TL / 128, 1024, tb, lds, EpiU{(bf16_t*)(p.ws + OFF_Y)});
      if (l == 0) run_gemm(wint + (size_t)WR_G * 1024, 1024, 8, hb + (size_t)TL * 1024, 1024, TC / 128, 1024, true, tb, lds, EpiU{(bf16_t*)(p.ws + OFF_Y) + (size_t)TL * 1024});
    } break;
    case 6: phase_merge(p, l, NTC, lds); break;
    case 7: {
      const bf16_t* wo = (const bf16_t*)(p.ws + OFF_WOUT) + (size_t)l * 1024 * 1024;
      const bf16_t* mb = (const bf16_t*)(p.ws + OFF_MBUF);
      bf16_t* ob = (bf16_t*)(p.ws + OFF_O);
      run_gemm_big(wo, 1024, 4, mb, 1024, TL / 128, 1024, tb, lds, EpiRowMajor{ob, 1024});
      if (l == 0) run_gemm(wo, 1024, 8, mb + (size_t)TL * 1024, 1024, TC / 128, 1024, true, tb, lds, EpiRowMajor{ob + (size_t)TL * 1024, 1024});
    } break;
    case 8: phase_final(p, l); break;
  }
}

__global__ void __launch_bounds__(256, 2) mega(P p) {
  __shared__ __attribute__((aligned(16))) char lds[69632];
  cg::grid_group grid = cg::this_grid();
  volatile LAS unsigned* st = (volatile LAS unsigned*)(lds + 69616);
  if (threadIdx.x == 0) { st[0] = 0u; st[1] = 0u; }
  __syncthreads();
  XcdBarrier xb = xcd_barrier_post((unsigned*)(p.ws + OFF_BAR), st);
  for (int ph = p.phase_lo; ph < p.phase_hi; ++ph) {
    if (ph == 10) continue;
    if (ph > p.phase_lo) {
      if (p.phase_hi > 4096) grid.sync();
      xcd_barrier(xb);
    }
    run_phase(p, ph, lds);
  }
}

extern "C" void kernel_launch(void* const* d_in, const int* in_sizes, int n_in, void* d_out, int out_size, void* d_ws, size_t ws_size, hipStream_t stream) {
  static int grid = 0;
  if (grid == 0) {
    int dev = 0, cus = 0, per_cu = 0;
    hipGetDevice(&dev);
    hipDeviceGetAttribute(&cus, hipDeviceAttributeMultiprocessorCount, dev);
    hipOccupancyMaxActiveBlocksPerMultiprocessor(&per_cu, (const void*)mega, 256, 0);
    if (per_cu < 1) per_cu = 1;
    if (per_cu > 2) per_cu = 2;
    grid = cus * per_cu;
    if (ws_size < WS_END) { fprintf(stderr, "kernel_launch: workspace too small: %zu < %zu\n", ws_size, (size_t)WS_END); grid = -1; }
  }
  if (grid < 0) return;
  P p{};
  const float** f = (const float**)&p;
  for (int i = 0; i < 24; ++i) f[i] = (const float*)d_in[i];
  p.out = (float*)d_out;
  p.ws = (char*)d_ws;
#if SINGLE_LAUNCH
  if (hipMemsetAsync((char*)d_ws + OFF_BAR, 0, XCD_BAR_WORDS * 4, stream) != hipSuccess) { fprintf(stderr, "kernel_launch: memset of the barrier words failed\n"); return; }
  p.phase_lo = 0; p.phase_hi = NPHASE;
  void* args[] = {&p};
  hipError_t e = hipLaunchCooperativeKernel((const void*)mega, dim3(grid), dim3(256), args, 0, stream);
  if (e != hipSuccess) fprintf(stderr, "cooperative launch failed: %s (grid %d)\n", hipGetErrorString(e), grid);
#else
  for (int ph = 0; ph < NPHASE; ++ph) {
    p.phase_lo = ph; p.phase_hi = ph + 1;
    hipLaunchKernelGGL(mega, dim3(grid), dim3(256), 0, stream, p);
  }
#endif
}
```
